# Optimizing an MI355X kernel written in HIP

```python
import math
import jax, jax.numpy as jnp
from jax import lax
import numpy as np

D_MODEL = 1024
BATCH = 32
SEQ = 2048
DEPTH = 4

N_A_LAYERS = (DEPTH + 1) // 2
N_B_LAYERS = DEPTH // 2
N_DENSE = (DEPTH + 1) // 2
N_MOE = DEPTH // 2

MLA_HEADS = 8
QK_NOPE = 128
QK_ROPE = 64
V_HEAD = 128
Q_LORA = 384
KV_LORA = 256
ROPE_THETA = 10000.0
Q_BLOCK = 128

SWA_HEADS = 16
SWA_KV_HEADS = 2
SWA_HEAD_DIM = 64
WINDOW = 128
BLOCK = 128

REL_BUCKETS = 32
REL_MAX_DIST = 128

D_FF = 2816
N_EXPERTS = 8
TOP_K = 2
D_FF_EXPERT = 3584

EPS = 1e-6
NEG_INF = -1e30

kernel_name = "yoco_mla_swa_sink_t5_moe_trunk"


def rmsnorm(x, g):
    xf = x.astype(jnp.float32)
    y = xf * lax.rsqrt(jnp.mean(xf * xf, axis=-1, keepdims=True) + EPS)
    return (y * g.astype(jnp.float32)).astype(x.dtype)


def rope(x, positions):
    half = x.shape[-1] // 2
    inv = ROPE_THETA ** (-jnp.arange(half, dtype=jnp.float32) / half)
    ang = positions.astype(jnp.float32)[..., None] * inv
    if x.ndim == 4:
        ang = ang[:, :, None, :]
    cos, sin = jnp.cos(ang), jnp.sin(ang)
    xf = x.astype(jnp.float32)
    x1, x2 = xf[..., :half], xf[..., half:]
    return jnp.concatenate([x1 * cos - x2 * sin, x2 * cos + x1 * sin], axis=-1).astype(x.dtype)


def t5_bucket(dist):
    n = jnp.maximum(dist, 0)
    max_exact = REL_BUCKETS // 2
    nf = jnp.maximum(n, 1).astype(jnp.float32)
    large = max_exact + (jnp.log(nf / max_exact) / math.log(REL_MAX_DIST / max_exact)
                         * (REL_BUCKETS - max_exact)).astype(jnp.int32)
    large = jnp.minimum(large, REL_BUCKETS - 1)
    return jnp.where(n < max_exact, n, large)


def mla(xn, positions, w_in, g_q, g_kv, w_uq, w_ukv, w_o):
    B, S, _ = xn.shape
    lat = xn @ w_in
    c_q = rmsnorm(lat[..., :Q_LORA], g_q)
    c_kv = rmsnorm(lat[..., Q_LORA:Q_LORA + KV_LORA], g_kv)
    k_rope = rope(lat[..., Q_LORA + KV_LORA:], positions)
    q = (c_q @ w_uq).reshape(B, S, MLA_HEADS, QK_NOPE + QK_ROPE)
    q_nope = q[..., :QK_NOPE]
    q_rope = rope(q[..., QK_NOPE:], positions)
    kv = (c_kv @ w_ukv).reshape(B, S, MLA_HEADS, QK_NOPE + V_HEAD)
    k_nope, v = kv[..., :QK_NOPE], kv[..., QK_NOPE:]
    scale = (QK_NOPE + QK_ROPE) ** -0.5
    nb = S // Q_BLOCK
    k_idx = jnp.arange(S)

    def to_blocks(t):
        return jnp.moveaxis(t.reshape(B, nb, Q_BLOCK, *t.shape[2:]), 1, 0)

    def block(args):
        qn, qr, i = args
        s = (jnp.einsum('bqhd,bkhd->bhqk', qn, k_nope, preferred_element_type=jnp.float32)
             + jnp.einsum('bqhr,bkr->bhqk', qr, k_rope, preferred_element_type=jnp.float32)) * scale
        q_idx = i * Q_BLOCK + jnp.arange(Q_BLOCK)
        s = jnp.where(k_idx[None, :] <= q_idx[:, None], s, NEG_INF)
        p = jax.nn.softmax(s, axis=-1).astype(v.dtype)
        return jnp.einsum('bhqk,bkhd->bqhd', p, v)

    o = lax.map(block, (to_blocks(q_nope), to_blocks(q_rope), jnp.arange(nb)))
    o = jnp.moveaxis(o, 0, 1).reshape(B, S, MLA_HEADS * V_HEAD)
    return o @ w_o


def shared_band_kv(h, positions, kv_g, kv_w, kv_b):
    B, S, _ = h.shape
    nb = S // BLOCK
    kv = rmsnorm(h, kv_g) @ kv_w + kv_b
    kvw = SWA_KV_HEADS * SWA_HEAD_DIM
    k = kv[..., :kvw].reshape(B, S, SWA_KV_HEADS, SWA_HEAD_DIM)
    v = kv[..., kvw:].reshape(B, S, SWA_KV_HEADS, SWA_HEAD_DIM)

    def band(t):
        pad = jnp.zeros((B, BLOCK) + t.shape[2:], t.dtype)
        tb = jnp.concatenate([pad, t], axis=1).reshape(B, nb + 1, BLOCK, *t.shape[2:])
        tb = jnp.concatenate([tb[:, :-1], tb[:, 1:]], axis=2)
        return jnp.moveaxis(tb, 1, 0)

    return band(k), band(v), band(positions)


def swa_sink(xn, positions, k_band, v_band, pos_band, rel_bias, w_q, b_q, sinks, w_o, b_o):
    B, S, _ = xn.shape
    nb = S // BLOCK
    G = SWA_HEADS // SWA_KV_HEADS
    scale = SWA_HEAD_DIM ** -0.5
    q = (xn @ w_q + b_q).reshape(B, nb, BLOCK, SWA_KV_HEADS, G, SWA_HEAD_DIM)
    q = jnp.moveaxis(q, 1, 0)
    qpos = jnp.moveaxis(positions.reshape(B, nb, BLOCK), 1, 0)
    off = jnp.arange(2 * BLOCK) - BLOCK
    rel_idx = jnp.arange(BLOCK)[:, None] - off[None, :]
    struct_ok = (rel_idx >= 0) & (rel_idx < WINDOW)
    sink = sinks.astype(jnp.float32).reshape(SWA_KV_HEADS, G)
    bias_tab = rel_bias.astype(jnp.float32).reshape(REL_BUCKETS, SWA_KV_HEADS, G)

    def block(args):
        qb, kb, vb, qp, kp, i = args
        s = jnp.einsum('bqhgd,bkhd->bhgqk', qb, kb, preferred_element_type=jnp.float32) * scale
        bucket = t5_bucket(qp[:, :, None] - kp[:, None, :])
        s = s + jnp.transpose(bias_tab[bucket], (0, 3, 4, 1, 2))
        valid = struct_ok & ((i * BLOCK + off) >= 0)[None, :]
        s = jnp.where(valid, s, NEG_INF)
        sink_col = jnp.broadcast_to(sink[None, :, :, None, None], s.shape[:-1] + (1,))
        p = jax.nn.softmax(jnp.concatenate([s, sink_col], axis=-1), axis=-1)[..., :-1]
        return jnp.einsum('bhgqk,bkhd->bqhgd', p.astype(vb.dtype), vb)

    o = lax.map(block, (q, k_band, v_band, qpos, pos_band, jnp.arange(nb)))
    o = jnp.moveaxis(o, 0, 1).reshape(B, S, SWA_HEADS * SWA_HEAD_DIM)
    return o @ w_o + b_o


def swiglu(xn, w_gate, w_up, w_down):
    return (jax.nn.silu(xn @ w_gate) * (xn @ w_up)) @ w_down


def moe(xn, w_router, w_gate, w_up, w_down):
    logits = (xn @ w_router).astype(jnp.float32)
    top_val, top_idx = lax.top_k(logits, TOP_K)
    top_w = jax.nn.softmax(top_val, axis=-1)
    gates = jnp.sum(jax.nn.one_hot(top_idx, N_EXPERTS, dtype=jnp.float32) * top_w[..., None], axis=-2)

    def per_seq(args):
        xs, gs = args
        hg = jnp.einsum('sd,edf->sef', xs, w_gate)
        hu = jnp.einsum('sd,edf->sef', xs, w_up)
        hh = jax.nn.silu(hg) * hu * gs[..., None].astype(xs.dtype)
        return jnp.einsum('sef,efd->sd', hh, w_down)

    return lax.map(per_seq, (xn, gates))


def setup_inputs(seed: int = 0) -> dict:
    key = jax.random.key(seed)
    ks = iter(jax.random.split(key, 40))
    f32 = jnp.float32

    def w(shape, fan_in):
        return jax.random.normal(next(ks), shape, f32) * (fan_in ** -0.5)

    def gain(shape):
        return 1.0 + 0.1 * jax.random.normal(next(ks), shape, f32)

    def small(shape, s=0.02):
        return s * jax.random.normal(next(ks), shape, f32)

    x = jax.random.normal(next(ks), (BATCH, SEQ, D_MODEL), f32)
    offset = jax.random.randint(next(ks), (BATCH, 1), 0, 1024, dtype=jnp.int32)
    positions = (offset + jnp.arange(SEQ, dtype=jnp.int32)[None, :]).astype(jnp.int32)
    kvw = SWA_KV_HEADS * SWA_HEAD_DIM
    return {
        "x": x,
        "positions": positions,
        "mla_w_in": w((N_A_LAYERS, D_MODEL, Q_LORA + KV_LORA + QK_ROPE), D_MODEL),
        "mla_g_q": gain((N_A_LAYERS, Q_LORA)),
        "mla_g_kv": gain((N_A_LAYERS, KV_LORA)),
        "mla_w_uq": w((N_A_LAYERS, Q_LORA, MLA_HEADS * (QK_NOPE + QK_ROPE)), Q_LORA),
        "mla_w_ukv": w((N_A_LAYERS, KV_LORA, MLA_HEADS * (QK_NOPE + V_HEAD)), KV_LORA),
        "mla_w_o": w((N_A_LAYERS, MLA_HEADS * V_HEAD, D_MODEL), MLA_HEADS * V_HEAD),
        "kv_g": gain((D_MODEL,)),
        "kv_w": w((D_MODEL, 2 * kvw), D_MODEL),
        "kv_b": small((2 * kvw,)),
        "swa_w_q": w((N_B_LAYERS, D_MODEL, SWA_HEADS * SWA_HEAD_DIM), D_MODEL),
        "swa_b_q": small((N_B_LAYERS, SWA_HEADS * SWA_HEAD_DIM)),
        "swa_sinks": small((N_B_LAYERS, SWA_HEADS), 0.5),
        "swa_w_o": w((N_B_LAYERS, SWA_HEADS * SWA_HEAD_DIM, D_MODEL), SWA_HEADS * SWA_HEAD_DIM),
        "swa_b_o": small((N_B_LAYERS, D_MODEL)),
        "rel_bias": small((REL_BUCKETS, SWA_HEADS), 0.5),
        "g_attn": gain((DEPTH, D_MODEL)),
        "g_ffn": gain((DEPTH, D_MODEL)),
        "ffn_w_gate": w((N_DENSE, D_MODEL, D_FF), D_MODEL),
        "ffn_w_up": w((N_DENSE, D_MODEL, D_FF), D_MODEL),
        "ffn_w_down": w((N_DENSE, D_FF, D_MODEL), D_FF),
        "moe_w_router": w((N_MOE, D_MODEL, N_EXPERTS), D_MODEL),
        "moe_w_gate": w((N_MOE, N_EXPERTS, D_MODEL, D_FF_EXPERT), D_MODEL),
        "moe_w_up": w((N_MOE, N_EXPERTS, D_MODEL, D_FF_EXPERT), D_MODEL),
        "moe_w_down": w((N_MOE, N_EXPERTS, D_FF_EXPERT, D_MODEL), D_FF_EXPERT),
        "g_final": gain((D_MODEL,)),
    }


def reference(x, positions, mla_w_in, mla_g_q, mla_g_kv, mla_w_uq, mla_w_ukv, mla_w_o,
              kv_g, kv_w, kv_b, swa_w_q, swa_b_q, swa_sinks, swa_w_o, swa_b_o, rel_bias,
              g_attn, g_ffn, ffn_w_gate, ffn_w_up, ffn_w_down,
              moe_w_router, moe_w_gate, moe_w_up, moe_w_down, g_final):
    h = x
    k_band = v_band = pos_band = None
    for l in range(DEPTH):
        xn = rmsnorm(h, g_attn[l])
        if l < N_A_LAYERS:
            a = l
            h = h + mla(xn, positions, mla_w_in[a], mla_g_q[a], mla_g_kv[a],
                        mla_w_uq[a], mla_w_ukv[a], mla_w_o[a])
        else:
            b = l - N_A_LAYERS
            if b == 0:
                k_band, v_band, pos_band = shared_band_kv(h, positions, kv_g, kv_w, kv_b)
            h = h + swa_sink(xn, positions, k_band, v_band, pos_band, rel_bias,
                             swa_w_q[b], swa_b_q[b], swa_sinks[b], swa_w_o[b], swa_b_o[b])
        xn = rmsnorm(h, g_ffn[l])
        if l % 2 == 0:
            j = l // 2
            h = h + swiglu(xn, ffn_w_gate[j], ffn_w_up[j], ffn_w_down[j])
        else:
            j = l // 2
            h = h + moe(xn, moe_w_router[j], moe_w_gate[j], moe_w_up[j], moe_w_down[j])
    return rmsnorm(h, g_final)
```

```cpp
#include <hip/hip_runtime.h>
#include <cstdio>
#include <cstdint>

#ifndef MK_PER_PHASE
#define MK_PER_PHASE 0
#endif

#ifndef F8_L0
#define F8_L0 1
#endif
#ifndef F8_L1
#define F8_L1 1
#endif
#ifndef F8_WOM
#define F8_WOM 1
#endif
#ifndef F8_WOS
#define F8_WOS 1
#endif
#ifndef F8_D1
#define F8_D1 1
#endif
#define GAS __attribute__((address_space(1)))
#define LAS __attribute__((address_space(3)))
typedef unsigned short bf16_t;
typedef short bf16x8 __attribute__((ext_vector_type(8)));
typedef short s16x4 __attribute__((ext_vector_type(4)));
typedef float f32x2 __attribute__((ext_vector_type(2)));
typedef float f32x4 __attribute__((ext_vector_type(4)));
typedef float f32x16 __attribute__((ext_vector_type(16)));
typedef unsigned u32x2 __attribute__((ext_vector_type(2)));
typedef unsigned u32x4 __attribute__((ext_vector_type(4)));
typedef int i32x4 __attribute__((ext_vector_type(4)));
typedef int i32x8 __attribute__((ext_vector_type(8)));

constexpr int T = 65536, DM = 1024, SEQ = 2048, NB = 32;
constexpr int QLORA = 384, KVLORA = 256, ROPE = 64, LATN = 704;
constexpr int DFF = 2816, DFE = 3584, NEXP = 8;
constexpr float EPS = 1e-6f;
constexpr int MOE_ROWS = T + NEXP * 256;

constexpr size_t MiB = 1u << 20;
constexpr size_t SZ_WIN = 768ull * 1024 * 2, SZ_WUQ = 1536ull * 384 * 2, SZ_WUKV = 2048ull * 256 * 2, SZ_WO = 1024ull * 1024 * 2;
constexpr size_t SZ_WQKV = 1280ull * 1024 * 2;
constexpr size_t SZ_WGU_D = 5632ull * 1024 * 2, SZ_WD_D = 1024ull * 2816 * 2;
constexpr size_t SZ_WGU_E0 = 7168ull * 1024 * (F8_L0 ? 1 : 2), SZ_WD_E0 = 1024ull * 3584 * (F8_L0 ? 1 : 2);
constexpr size_t SZ_WGU_E1 = 7168ull * 1024 * (F8_L1 ? 1 : 2), SZ_WD_E1 = 1024ull * 3584 * (F8_L1 ? 1 : 2);
constexpr float SCALE_O = 32.0f;
constexpr float SCALE_A8 = 0.125f, SCALE_WG8 = -1.4426950408889634f / SCALE_A8, SCALE_WU8 = -0.6931471805599453f / SCALE_A8;
constexpr float SCALE_GU = 32.0f, SCALE_D = 64.0f;
constexpr size_t SZ_WR = 8ull * 1024 * 4;
constexpr size_t WS_CTL = 0, CTL_BYTES = 1 * MiB;
constexpr size_t WS_WIN = 1 * MiB;
constexpr size_t WS_WUQ = WS_WIN + 2 * SZ_WIN;
constexpr size_t WS_WUKV = WS_WUQ + 2 * SZ_WUQ;
constexpr size_t WS_WOM = WS_WUKV + 2 * SZ_WUKV;
constexpr size_t WS_WQKV = WS_WOM + 2 * SZ_WO;
constexpr size_t WS_WOS = WS_WQKV + 2 * SZ_WQKV;
constexpr size_t WS_WGUD = WS_WOS + 2 * SZ_WO;
constexpr size_t WS_WDD = WS_WGUD + 2 * SZ_WGU_D;
constexpr size_t WS_WGUE0 = WS_WDD + 2 * SZ_WD_D;
constexpr size_t WS_WGUE1 = WS_WGUE0 + 8 * SZ_WGU_E0;
constexpr size_t WS_WDE0 = WS_WGUE1 + 8 * SZ_WGU_E1;
constexpr size_t WS_WDE1 = WS_WDE0 + 8 * SZ_WD_E0;
constexpr size_t WS_WR = WS_WDE1 + 8 * SZ_WD_E1;
constexpr size_t WS_WEND = WS_WR + 2 * SZ_WR;
constexpr size_t WS_H = (WS_WEND + MiB - 1) / MiB * MiB;
constexpr size_t WS_SS = WS_H + (size_t)T * DM * 2;
constexpr size_t WS_KVB = WS_SS + (size_t)T * 16 * 4;
constexpr size_t WS_ROUTE = WS_KVB + (size_t)T * 256 * 2;
constexpr size_t RT_TOKE = 0, RT_TOKW = RT_TOKE + (size_t)T * 4, RT_RANK = RT_TOKW + (size_t)T * 8, RT_CNT = RT_RANK + (size_t)T * 8,
                 RT_IDX = RT_CNT + 256 * 16 * 4, RT_WL = RT_IDX + 2ull * MOE_ROWS * 4, RT_TEXP = RT_WL + 2ull * MOE_ROWS * 4, RT_RSL = RT_TEXP + 2 * 512 * 4, RT_PCNT = RT_RSL + 2ull * MOE_ROWS * 4, RT_END = RT_PCNT + 256 * 64 * 4;
static_assert(RT_END <= 3 * MiB, "route tables");
constexpr size_t WS_ARENA = WS_ROUTE + 3 * MiB;
constexpr size_t AR_CQ = 0, AR_CKV = AR_CQ + (size_t)T * 384 * 2, AR_KR = AR_CKV + (size_t)T * 256 * 2, AR_Q = AR_KR + (size_t)T * 64 * 2,
                 AR_O = AR_Q + (size_t)T * 1536 * 2, AR_MLA_END = AR_O + (size_t)T * 1024 * 2;
constexpr size_t AR_CS = AR_MLA_END, AR_SSLAT = AR_CS + (size_t)T * 64 * 4, AR_X_END = AR_SSLAT + (size_t)T * 16 * 4;
constexpr size_t AR_H8 = 256 * MiB;
constexpr size_t AR_ACT = 0;
constexpr size_t AR_SQ = 0, AR_SO = (size_t)T * 1024 * 2;
constexpr size_t AR_ACTB = 320 * MiB;
constexpr size_t ARENA_BYTES = AR_ACTB + (size_t)MOE_ROWS * DFE;
static_assert(AR_X_END <= ARENA_BYTES && (size_t)T * DFF * 2 <= AR_CS && (size_t)MOE_ROWS * DFE * 2 <= ARENA_BYTES && AR_H8 + (size_t)T * DM <= AR_ACTB, "arena overlays");
constexpr size_t WS_END = WS_ARENA + ARENA_BYTES;

constexpr int CW_BAR = 4096;

constexpr int RING_BYTES = 131072;
constexpr int LDSCTL_OFF = RING_BYTES, MISC_OFF = LDSCTL_OFF + 320;
constexpr int LX_POS = RING_BYTES + 512;
constexpr int LX_BIAS = LX_POS + 1536;
constexpr int LX_WSC = LX_BIAS + 8448;
constexpr int LDS_BYTES = 147456;
static_assert(LX_WSC + 2048 <= LDS_BYTES, "LDS map");

__device__ __forceinline__ unsigned cvtpk(float lo, float hi) { unsigned r; asm volatile("v_cvt_pk_bf16_f32 %0, %1, %2" : "=v"(r) : "v"(lo), "v"(hi)); return r; }
__device__ __forceinline__ u32x4 pack8u(f32x4 a, f32x4 b) { u32x4 w; w.x = cvtpk(a[0], a[1]); w.y = cvtpk(a[2], a[3]); w.z = cvtpk(b[0], b[1]); w.w = cvtpk(b[2], b[3]); return w; }
__device__ __forceinline__ void store8(bf16_t* p, f32x4 a, f32x4 b) { *(u32x4*)p = pack8u(a, b); }
__device__ __forceinline__ void unpack8(u32x4 w, f32x4& a, f32x4& b) {
    a[0] = __uint_as_float(w.x << 16); a[1] = __uint_as_float(w.x & 0xffff0000u); a[2] = __uint_as_float(w.y << 16); a[3] = __uint_as_float(w.y & 0xffff0000u);
    b[0] = __uint_as_float(w.z << 16); b[1] = __uint_as_float(w.z & 0xffff0000u); b[2] = __uint_as_float(w.w << 16); b[3] = __uint_as_float(w.w & 0xffff0000u);
}
__device__ __forceinline__ unsigned pack4_fp8(f32x4 v) { int w = 0; w = __builtin_amdgcn_cvt_pk_fp8_f32(v[0], v[1], w, false); w = __builtin_amdgcn_cvt_pk_fp8_f32(v[2], v[3], w, true); return (unsigned)w; }
__device__ __forceinline__ float sq4(f32x4 v) { return (v[0] * v[0] + v[1] * v[1]) + (v[2] * v[2] + v[3] * v[3]); }
__device__ __forceinline__ float red_fq(float s) { s += __shfl_xor(s, 16); s += __shfl_xor(s, 32); return s; }
__device__ __forceinline__ float wave_sum(float v) {
#pragma unroll
    for (int o = 1; o < 64; o <<= 1) v += __shfl_xor(v, o);
    return v;
}
template <int NS> __device__ __forceinline__ float row_rstd(const float* ss, size_t row, int slot_lo, float inv_dim, int fq) {
    float s = 0.f;
    if (NS == 16 || 4 * fq < NS) { const f32x4 v = *(const f32x4*)(ss + row * 16 + slot_lo + 4 * fq); s = (v[0] + v[1]) + (v[2] + v[3]); }
    s = red_fq(s);
    return 1.0f / sqrtf(s * inv_dim + EPS);
}
__device__ __forceinline__ f32x4 silu_mul_rs(f32x4 g, f32x4 u, float c1, float c2) {
    f32x4 r;
#pragma unroll
    for (int e = 0; e < 4; ++e) { const float s = __builtin_amdgcn_rcpf(1.0f + __builtin_amdgcn_exp2f(c1 * g[e])); float t = c2 * s; t = u[e] * t; r[e] = g[e] * t; }
    return r;
}
__device__ __forceinline__ void rope4(f32x4 x1, f32x4 x2, f32x4 ta, f32x4 tb, f32x4& o1, f32x4& o2) {
    o1[0] = x1[0] * ta[0] - x2[0] * ta[1]; o2[0] = x2[0] * ta[0] + x1[0] * ta[1];
    o1[1] = x1[1] * ta[2] - x2[1] * ta[3]; o2[1] = x2[1] * ta[2] + x1[1] * ta[3];
    o1[2] = x1[2] * tb[0] - x2[2] * tb[1]; o2[2] = x2[2] * tb[0] + x1[2] * tb[1];
    o1[3] = x1[3] * tb[2] - x2[3] * tb[3]; o2[3] = x2[3] * tb[2] + x1[3] * tb[3];
}

namespace pg8 {
constexpr int BM = 256, BK = 64, HALF = 128, HTB = HALF * BK * 2, STAGE_BYTES = 8 * HTB, NXCD = 8, WGM = 8;
__host__ __device__ __forceinline__ int lds_byte(int r, int c) { const int st = (r >> 4) * 2 + (c >> 5), rr = r & 15, cc = c & 31, ob = rr * 64 + cc * 2; return st * 1024 + (ob ^ (((ob >> 9) & 1) << 5)); }
__host__ __device__ __forceinline__ void stage_rc(int b, int& R, int& C) { const int st = b / 1024, sb = b % 1024, swz = sb ^ (((sb >> 9) & 1) << 5); R = (st >> 1) * 16 + swz / 64; C = (st & 1) * 32 + (swz % 64) / 2; }
__host__ __device__ __forceinline__ int perm32(int rho) { const int n = rho >> 4, i = rho & 15; return 8 * (i >> 2) + 4 * n + (i & 3); }
struct Unit { int pm, pn; };
__device__ __forceinline__ void glds16_x2(const void* sbase, unsigned voff0, unsigned voff1, unsigned ldsaddr) {
    asm volatile("s_mov_b32 m0, %3\n\ts_nop 0\n\tglobal_load_lds_dwordx4 %0, %2\n\ts_mov_b32 m0, %4\n\ts_nop 0\n\tglobal_load_lds_dwordx4 %1, %2" :: "v"(voff0), "v"(voff1), "s"(sbase), "s"(ldsaddr), "s"(ldsaddr + 8192u) : "memory"); }

struct Sched {
    int nM, nN; const char* Bt; size_t tstepB; const int* texp; size_t estride; const int* idx;
    int per, kq, start, len, skipme, pe, ke, base;
    static constexpr int ESKIP = 3;
    __device__ __forceinline__ void init(int nM_, int nN_, int K, int G_, int c_, const void* Bt_, int esz = 2) { nM = nM_; nN = nN_; Bt = (const char*)Bt_; tstepB = (size_t)BM * K * esz; texp = nullptr; estride = 0; idx = nullptr;
        const int nwg = nM * nN, x = c_ % NXCD, q = nwg / NXCD, r = nwg % NXCD; per = G_ / NXCD; kq = c_ / NXCD; len = q + (x < r ? 1 : 0); start = x * q + (x < r ? x : r);
        skipme = 0; pe = per; ke = kq; base = kq; xq = x; }
    int xq;
    __device__ __forceinline__ void skip(int rE) { const int ex = rE > xq ? (rE - xq + NXCD - 1) / NXCD : 0; skipme = kq < ex ? ESKIP : 0; pe = per - ex; ke = kq - ex; base = kq - ESKIP * ex; }
    __device__ __forceinline__ bool next(int i, Unit& u) const {
        const int ii = i + skipme, jv = ii < ESKIP ? ii * pe + ke : base + ii * per;
        if (jv >= len) return false;
        const int wgid = start + jv;
        const int nig = WGM * nN, gid = wgid / nig, fm = gid * WGM, gsz = (nM - fm) < WGM ? (nM - fm) : WGM;
        u.pm = fm + ((wgid % nig) % gsz); u.pn = (wgid % nig) / gsz; return true;
    }
    __device__ __forceinline__ const char* bptr(const Unit& u) const { const size_t e = texp ? (size_t)texp[u.pm] * estride : 0; return Bt + e + (size_t)u.pn * tstepB; }
    __device__ __forceinline__ void arows(const Unit& u, int tid_, int rowB, unsigned (&off)[2][2]) const {
        asm volatile("" : "+v"(tid_));
#pragma unroll
        for (int i = 0; i < 2; ++i) { int R, C; stage_rc(tid_ * 16 + i * 8192, R, C);
#pragma unroll
            for (int h = 0; h < 2; ++h) { int tok = idx[u.pm * BM + h * HALF + R]; tok = tok < 0 ? 0 : tok; off[h][i] = (unsigned)tok * (unsigned)rowB + (unsigned)(C * 2); } }
    }
};

template <class Epi, bool GATHER, bool F8 = false>
__device__ __forceinline__ void gemm_phase(LAS unsigned char* lds, const void* Abase, const int K, const Sched& S, const Epi& E) {
    int tid = threadIdx.x; asm volatile("" : "+v"(tid));
    const int wid = __builtin_amdgcn_readfirstlane(tid >> 6), lane = tid & 63, wr = wid >> 2, wc = wid & 3, fr = lane & 15, fq = lane >> 4;
    const int rowB = F8 ? K : 2 * K;
    const int nt = rowB / 128;
    int Rr[2], Cc[2]; unsigned voffB[2];
#pragma unroll
    for (int i = 0; i < 2; ++i) { int R, C; stage_rc(tid * 16 + i * 8192, R, C); Rr[i] = R; Cc[i] = C; const int Rb = (R & ~31) + perm32(R & 31); voffB[i] = (unsigned)(Rb * rowB + C * 2); }
    const size_t kstep = (size_t)(BK * 2);
    const size_t hstep = (size_t)HALF * rowB;
    const size_t tstep = 2 * hstep;
    const unsigned ldsw = (unsigned)wid * 1024u;
    const unsigned ldsbase = (unsigned)(uintptr_t)lds;
    const int aoff = lds_byte(wr * 64 + fr, fq * 8), boff = lds_byte(wc * 32 + fr, fq * 8);
#define PG8_SA(b, h) (((b) * 2 + (h)) * HTB)
#define PG8_SB(b, h) ((4 + (b) * 2 + (h)) * HTB)
#define PG8_STAGE(bufoff, gbase, voff) glds16_x2((const void*)(gbase), (voff)[0], (voff)[1], ldsbase + (unsigned)(bufoff) + ldsw)
#define PG8_LDA(dst, b, h) do { _Pragma("unroll") for (int m = 0; m < 4; ++m) _Pragma("unroll") for (int k = 0; k < 2; ++k) dst[m][k] = *(const LAS bf16x8*)(lds + PG8_SA(b, h) + aoff + m * 2048 + k * 1024); } while (0)
#define PG8_LDB(dst, b, h) do { _Pragma("unroll") for (int n = 0; n < 2; ++n) _Pragma("unroll") for (int k = 0; k < 2; ++k) dst[n][k] = *(const LAS bf16x8*)(lds + PG8_SB(b, h) + boff + n * 2048 + k * 1024); } while (0)
#define PG8_F8OP(X) __builtin_shufflevector(__builtin_bit_cast(i32x4, X[0]), __builtin_bit_cast(i32x4, X[1]), 0, 1, 2, 3, 4, 5, 6, 7)
#define PG8_MMA(ai, bj, At, Bt) do { __builtin_amdgcn_s_setprio(1); _Pragma("unroll") for (int m = 0; m < 4; ++m) _Pragma("unroll") for (int n = 0; n < 2; ++n) { \
        if constexpr (F8) { f32x16& B_ = big[(ai) * 4 + (bj) * 2 + (m >> 1)]; constexpr int o_ = 0; const int q_ = ((m & 1) * 2 + n) * 4; (void)o_; \
            f32x4 s_ = {B_[q_], B_[q_ + 1], B_[q_ + 2], B_[q_ + 3]}; \
            s_ = __builtin_amdgcn_mfma_scale_f32_16x16x128_f8f6f4(PG8_F8OP(Bt[n]), PG8_F8OP(At[m]), s_, 0, 0, 0, 0, 0, 0); \
            B_[q_] = s_[0]; B_[q_ + 1] = s_[1]; B_[q_ + 2] = s_[2]; B_[q_ + 3] = s_[3]; } \
        else { _Pragma("unroll") for (int k = 0; k < 2; ++k) acc[ai][bj][m][n] = __builtin_amdgcn_mfma_f32_16x16x32_bf16(Bt[n][k], At[m][k], acc[ai][bj][m][n], 0, 0, 0); } } __builtin_amdgcn_s_setprio(0); } while (0)
#define PG8_WAIT_V(n) asm volatile("s_waitcnt vmcnt(" #n ")" ::: "memory")
#define PG8_WAIT_L(n) asm volatile("s_waitcnt lgkmcnt(" #n ")" ::: "memory")
#define PG8_BAR __builtin_amdgcn_s_barrier()
#define PG8_SCHED __builtin_amdgcn_sched_barrier(0)
    Unit cur, nxt; int ui = 0;
    if (!S.next(0, cur)) return;
    f32x4 acc[2][2][4][2];
#pragma unroll
    for (int a = 0; a < 2; ++a)
#pragma unroll
        for (int b = 0; b < 2; ++b)
#pragma unroll
            for (int m = 0; m < 4; ++m)
#pragma unroll
                for (int n = 0; n < 2; ++n) acc[a][b][m][n] = (f32x4){0.f, 0.f, 0.f, 0.f};
    bf16x8 At[4][2], B0[2][2], B1[2][2];
    f32x16 big[8];
    if constexpr (F8) {
#pragma unroll
        for (int i = 0; i < 8; ++i) big[i] = f32x16{}; }
    unsigned cvo[2][2], nvo[2][2];
    const char* cA; const char* cB = S.bptr(cur);
    if constexpr (GATHER) { cA = (const char*)Abase; S.arows(cur, tid, rowB, cvo); }
    else { cA = (const char*)Abase + (size_t)cur.pm * tstep;
#pragma unroll
        for (int h = 0; h < 2; ++h)
#pragma unroll
            for (int i = 0; i < 2; ++i) cvo[h][i] = (unsigned)((h * HALF + Rr[i]) * rowB + Cc[i] * 2); }
    PG8_STAGE(PG8_SB(0, 0), cB, voffB); PG8_STAGE(PG8_SB(0, 1), cB + hstep, voffB); PG8_STAGE(PG8_SA(0, 0), cA, cvo[0]); PG8_STAGE(PG8_SA(0, 1), cA, cvo[1]);
    if (wr == 1) PG8_BAR;
    PG8_WAIT_V(2); PG8_BAR;
    PG8_STAGE(PG8_SB(1, 0), cB + kstep, voffB); PG8_STAGE(PG8_SA(1, 0), cA + kstep, cvo[0]); PG8_STAGE(PG8_SB(1, 1), cB + hstep + kstep, voffB);
    PG8_WAIT_V(6); PG8_BAR;
    for (;;) {
        const bool has_next = S.next(ui + 1, nxt);
        const char* nA; const char* nB;
        if (has_next) { nB = S.bptr(nxt);
            if constexpr (GATHER) { nA = (const char*)Abase;
                if (nxt.pm != cur.pm) S.arows(nxt, tid, rowB, nvo);
                else {
#pragma unroll
                    for (int h = 0; h < 2; ++h)
#pragma unroll
                        for (int i = 0; i < 2; ++i) nvo[h][i] = cvo[h][i]; } }
            else { nA = (const char*)Abase + (size_t)nxt.pm * tstep; } }
        else { nA = cA; nB = cB;
            if constexpr (GATHER) {
#pragma unroll
                for (int h = 0; h < 2; ++h)
#pragma unroll
                    for (int i = 0; i < 2; ++i) nvo[h][i] = cvo[h][i]; } }
#pragma unroll 1
        for (int t = 0; t < nt; t += 2) {
            const bool last = (t == nt - 2);
            const char* a1 = cA + (size_t)(t + 1) * kstep;
            const char* a2 = last ? nA : cA + (size_t)(t + 2) * kstep; const char* b2 = last ? nB : cB + (size_t)(t + 2) * kstep;
            const char* a3 = a2 + kstep; const char* b3 = b2 + kstep;
            unsigned v2[2][2];
#pragma unroll
            for (int h = 0; h < 2; ++h)
#pragma unroll
                for (int i = 0; i < 2; ++i) { if constexpr (GATHER) v2[h][i] = last ? nvo[h][i] : cvo[h][i]; else v2[h][i] = cvo[h][i]; }
            PG8_LDB(B0, 0, 0); PG8_LDB(B1, 0, 1); PG8_SCHED; PG8_LDA(At, 0, 0); PG8_STAGE(PG8_SA(1, 1), a1, cvo[1]);
            PG8_WAIT_V(8); PG8_WAIT_L(0); PG8_BAR; PG8_MMA(0, 0, At, B0); PG8_MMA(0, 1, At, B1); PG8_BAR; PG8_SCHED;
            PG8_LDA(At, 0, 1); PG8_STAGE(PG8_SB(0, 0), b2, voffB); PG8_STAGE(PG8_SB(0, 1), b2 + hstep, voffB); PG8_STAGE(PG8_SA(0, 0), a2, v2[0]);
            PG8_WAIT_V(8); PG8_WAIT_L(0); PG8_BAR; PG8_MMA(1, 0, At, B0); PG8_MMA(1, 1, At, B1); PG8_BAR; PG8_SCHED;
            PG8_LDB(B0, 1, 0); PG8_LDB(B1, 1, 1); PG8_SCHED; PG8_LDA(At, 1, 0); PG8_STAGE(PG8_SA(0, 1), a2, v2[1]);
            PG8_WAIT_V(8); PG8_WAIT_L(0); PG8_BAR; PG8_MMA(0, 0, At, B0); PG8_MMA(0, 1, At, B1); PG8_BAR; PG8_SCHED;
            PG8_LDA(At, 1, 1); PG8_STAGE(PG8_SB(1, 0), b3, voffB); PG8_STAGE(PG8_SB(1, 1), b3 + hstep, voffB); PG8_STAGE(PG8_SA(1, 0), a3, v2[0]);
            PG8_WAIT_V(8); PG8_WAIT_L(0); PG8_BAR; PG8_MMA(1, 0, At, B0); PG8_MMA(1, 1, At, B1); PG8_BAR; PG8_SCHED;
        }
        if (wr == 0) PG8_BAR;
        if constexpr (F8) {
#pragma unroll
            for (int a = 0; a < 2; ++a)
#pragma unroll
                for (int b = 0; b < 2; ++b)
#pragma unroll
                    for (int m = 0; m < 4; ++m)
#pragma unroll
                        for (int n = 0; n < 2; ++n) { const f32x16& B_ = big[a * 4 + b * 2 + (m >> 1)]; const int q_ = ((m & 1) * 2 + n) * 4; acc[a][b][m][n] = (f32x4){B_[q_], B_[q_ + 1], B_[q_ + 2], B_[q_ + 3]}; }
        }
        { int fr_ = fr, fq_ = fq; asm volatile("" : "+v"(fr_), "+v"(fq_));
          E(acc, cur, wr, wc, fr_, fq_); }
        if constexpr (F8) {
            u32x4 zz; asm volatile("v_mov_b32 %0, 0\n\tv_mov_b32 %1, 0\n\tv_mov_b32 %2, 0\n\tv_mov_b32 %3, 0" : "=v"(zz.x), "=v"(zz.y), "=v"(zz.z), "=v"(zz.w)); const bf16x8 z8 = __builtin_bit_cast(bf16x8, zz);
#pragma unroll
            for (int i = 0; i < 8; ++i) { asm volatile("" : "+v"(zz)); const bf16x8 zi = __builtin_bit_cast(bf16x8, zz); big[i] = __builtin_amdgcn_mfma_f32_32x32x16_bf16(zi, zi, f32x16{}, 0, 0, 0); } }
        if (!has_next) break;
#pragma unroll
        for (int a = 0; a < 2; ++a)
#pragma unroll
            for (int b = 0; b < 2; ++b)
#pragma unroll
                for (int m = 0; m < 4; ++m)
#pragma unroll
                    for (int n = 0; n < 2; ++n) acc[a][b][m][n] = (f32x4){0.f, 0.f, 0.f, 0.f};
        cur = nxt; cA = nA; cB = nB; ++ui;
        if constexpr (GATHER) {
#pragma unroll
            for (int h = 0; h < 2; ++h)
#pragma unroll
                for (int i = 0; i < 2; ++i) cvo[h][i] = nvo[h][i]; }
        if (wr == 1) PG8_BAR;
    }
    PG8_WAIT_V(0);
    PG8_BAR;
#undef PG8_SA
#undef PG8_SB
#undef PG8_STAGE
#undef PG8_LDA
#undef PG8_LDB
#undef PG8_F8OP
#undef PG8_MMA
#undef PG8_WAIT_V
#undef PG8_WAIT_L
#undef PG8_BAR
#undef PG8_SCHED
}
}
using pg8::Unit;
typedef const f32x4 (&AccRef)[2][2][4][2];

#define EPI_G(g) const int ai = (g) >> 2, m = (g) & 3, rowc = ai * 128 + m * 16; (void)ai; (void)m; (void)rowc
__device__ __forceinline__ void store8c(char* p, f32x4 a, f32x4 b) { *(u32x4*)p = pack8u(a, b); }
template <int NS> __device__ __forceinline__ void ss_load8(f32x4 (&v)[8], const char* ssu, unsigned slo, int fq) {
#pragma unroll
    for (int g = 0; g < 8; ++g) { EPI_G(g); v[g] = (f32x4){0.f, 0.f, 0.f, 0.f}; if (NS == 16 || 4 * fq < NS) v[g] = *(const f32x4*)(ssu + slo + rowc * 64); }
}
__device__ __forceinline__ float ss_rstd(f32x4 v, float inv_dim) { float s = (v[0] + v[1]) + (v[2] + v[3]); s = red_fq(s); return 1.0f / sqrtf(s * inv_dim + EPS); }
struct EpiLat {
    const float* ssh; bf16_t* CQ; bf16_t* CKV; bf16_t* KR; float* sslat; const float* cs;
    __device__ __forceinline__ void operator()(AccRef acc, const Unit& u, int wr, int wc, int fr, int fq) const {
        const size_t rowU = (size_t)u.pm * 256 + wr * 64;
        const char* ssu = (const char*)(ssh + rowU * 16); const unsigned slo = (unsigned)(fr * 16 + 4 * fq) * 4u;
        char* sso = (char*)(sslat + rowU * 16); const unsigned sso_l = (unsigned)(fr * 16) * 4u;
        char* cqu = (char*)(CQ + rowU * 384); const unsigned cql = (unsigned)(fr * 384 + fq * 8) * 2u;
        char* cku = (char*)(CKV + rowU * 256 + wc * 32); const unsigned ckl = (unsigned)(fr * 256 + fq * 8) * 2u;
        char* kru = (char*)(KR + rowU * 64); const unsigned krl = (unsigned)(fr * 64 + fq * 8) * 2u;
        const char* csu = (const char*)(cs + rowU * 64); const unsigned csl = (unsigned)(fr * 64 + fq * 16) * 4u;
        float rsv[8];
        { f32x4 sv[8]; ss_load8<16>(sv, ssu, slo, fq);
#pragma unroll
          for (int g = 0; g < 8; ++g) rsv[g] = ss_rstd(sv[g], 1.0f / 1024.0f); }
        asm volatile("" ::: "memory");
        const bool ropew = (u.pn == 1 && wc == 0);
#pragma unroll
        for (int gb = 0; gb < 8; gb += 2) {
            f32x4 ct[2][4];
            if (ropew) {
#pragma unroll
                for (int gg = 0; gg < 2; ++gg) { EPI_G(gb + gg); const f32x4* cp = (const f32x4*)(csu + csl + rowc * 256); ct[gg][0] = cp[0]; ct[gg][1] = cp[1]; ct[gg][2] = cp[2]; ct[gg][3] = cp[3]; }
            }
#pragma unroll
            for (int gg = 0; gg < 2; ++gg) { EPI_G(gb + gg);
                const float rs = rsv[gb + gg];
                const f32x4 v00 = acc[ai][0][m][0] * rs, v01 = acc[ai][0][m][1] * rs, v10 = acc[ai][1][m][0] * rs, v11 = acc[ai][1][m][1] * rs;
                float sq = (sq4(v00) + sq4(v01)) + (sq4(v10) + sq4(v11));
                int slot;
                if (u.pn == 0) { store8c(cqu + cql + (rowc * 384 + wc * 32) * 2, v00, v01); store8c(cqu + cql + (rowc * 384 + 128 + wc * 32) * 2, v10, v11); slot = wc; }
                else if (u.pn == 2) { store8c(cku + ckl + rowc * 512, v00, v01); store8c(cku + ckl + rowc * 512 + 256, v10, v11); slot = 8 + wc; }
                else { slot = 4 + wc;
                    if (wc == 0) { f32x4 a0, a1, b0, b1;
                        rope4(v00, v10, ct[gg][0], ct[gg][1], a0, b0); rope4(v01, v11, ct[gg][2], ct[gg][3], a1, b1);
                        store8c(kru + krl + rowc * 128, a0, a1); store8c(kru + krl + rowc * 128 + 64, b0, b1); sq = 0.f; }
                    else { store8c(cqu + cql + (rowc * 384 + 256 + (wc - 1) * 32) * 2, v00, v01); if (wc == 1) store8c(cqu + cql + (rowc * 384 + 352) * 2, v10, v11); } }
                sq = red_fq(sq);
                if (fq == 0) *(float*)(sso + sso_l + rowc * 64 + slot * 4) = sq;
            }
        }
    }
};
struct EpiQ {
    const float* sslat; bf16_t* Q; const float* cs;
    __device__ __forceinline__ void operator()(AccRef acc, const Unit& u, int wr, int wc, int fr, int fq) const {
        const size_t rowU = (size_t)u.pm * 256 + wr * 64;
        const char* ssu = (const char*)(sslat + rowU * 16); const unsigned slo = (unsigned)(fr * 16 + 4 * fq) * 4u;
        char* qu = (char*)(Q + rowU * 1536); const unsigned ql = (unsigned)(fr * 1536 + fq * 8) * 2u;
        const char* csu = (const char*)(cs + rowU * 64); const unsigned csl = (unsigned)(fr * 64 + fq * 16) * 4u;
        const int hh = (u.pn - 4) * 4 + wc;
        float rsv[8];
        { f32x4 sv[8]; ss_load8<8>(sv, ssu, slo, fq);
#pragma unroll
          for (int g = 0; g < 8; ++g) rsv[g] = ss_rstd(sv[g], 1.0f / 384.0f); }
        asm volatile("" ::: "memory");
        const bool ropet = (u.pn >= 4);
#pragma unroll
        for (int gb = 0; gb < 8; gb += 4) {
            f32x4 ct[4][4];
            if (ropet) {
#pragma unroll
                for (int gg = 0; gg < 4; ++gg) { EPI_G(gb + gg); const f32x4* cp = (const f32x4*)(csu + csl + rowc * 256); ct[gg][0] = cp[0]; ct[gg][1] = cp[1]; ct[gg][2] = cp[2]; ct[gg][3] = cp[3]; }
            }
#pragma unroll
            for (int gg = 0; gg < 4; ++gg) { EPI_G(gb + gg);
                const float rs = rsv[gb + gg];
                const f32x4 v00 = acc[ai][0][m][0] * rs, v01 = acc[ai][0][m][1] * rs, v10 = acc[ai][1][m][0] * rs, v11 = acc[ai][1][m][1] * rs;
                if (!ropet) { store8c(qu + ql + (rowc * 1536 + (2 * u.pn) * 192 + wc * 32) * 2, v00, v01); store8c(qu + ql + (rowc * 1536 + (2 * u.pn + 1) * 192 + wc * 32) * 2, v10, v11); }
                else { f32x4 a0, a1, b0, b1;
                    rope4(v00, v10, ct[gg][0], ct[gg][1], a0, b0); rope4(v01, v11, ct[gg][2], ct[gg][3], a1, b1);
                    store8c(qu + ql + (rowc * 1536 + hh * 192 + 128) * 2, a0, a1); store8c(qu + ql + (rowc * 1536 + hh * 192 + 160) * 2, b0, b1); }
            }
        }
    }
};
template <int NS> struct EpiScale {
    const float* ss; int slot_lo; float inv_dim; bf16_t* O; int pitch;
    __device__ __forceinline__ void operator()(AccRef acc, const Unit& u, int wr, int wc, int fr, int fq) const {
        const size_t rowU = (size_t)u.pm * 256 + wr * 64;
        const char* ssu = (const char*)(ss + rowU * 16 + slot_lo); const unsigned slo = (unsigned)(fr * 16 + 4 * fq) * 4u;
        char* ou = (char*)(O + rowU * pitch + u.pn * 256 + wc * 32); const unsigned ol = (unsigned)(fr * pitch + fq * 8) * 2u;
        f32x4 sv[8]; ss_load8<NS>(sv, ssu, slo, fq);
#pragma unroll
        for (int g = 0; g < 8; ++g) { EPI_G(g);
            const float rs = ss_rstd(sv[g], inv_dim);
            char* p = ou + ol + (size_t)rowc * pitch * 2;
            store8c(p, acc[ai][0][m][0] * rs, acc[ai][0][m][1] * rs); store8c(p + 256, acc[ai][1][m][0] * rs, acc[ai][1][m][1] * rs);
        }
    }
};
struct EpiSwaQkv {
    const float* ssh; bf16_t* Q; bf16_t* KVB; const float* bq; const float* kvb;
    __device__ __forceinline__ void operator()(AccRef acc, const Unit& u, int wr, int wc, int fr, int fq) const {
        const bool iskv = (u.pn == 4);
        const size_t rowU = (size_t)u.pm * 256 + wr * 64;
        const char* bpu = (const char*)((iskv ? kvb : bq + u.pn * 256) + wc * 32); const unsigned bl = (unsigned)(fq * 8) * 4u;
        const f32x4 b00 = *(const f32x4*)(bpu + bl), b01 = *(const f32x4*)(bpu + bl + 16), b10 = *(const f32x4*)(bpu + bl + 512), b11 = *(const f32x4*)(bpu + bl + 528);
        const char* ssu = (const char*)(ssh + rowU * 16); const unsigned slo = (unsigned)(fr * 16 + 4 * fq) * 4u;
        const int pitch = iskv ? 256 : 1024;
        char* ou = iskv ? (char*)(KVB + rowU * 256 + wc * 32) : (char*)(Q + rowU * 1024 + u.pn * 256 + wc * 32); const unsigned ol = (unsigned)(fr * pitch + fq * 8) * 2u;
        f32x4 sv[8]; ss_load8<16>(sv, ssu, slo, fq);
#pragma unroll
        for (int g = 0; g < 8; ++g) { EPI_G(g);
            const float rs = ss_rstd(sv[g], 1.0f / 1024.0f);
            char* p = ou + ol + (size_t)rowc * pitch * 2;
            store8c(p, acc[ai][0][m][0] * rs + b00, acc[ai][0][m][1] * rs + b01); store8c(p + 256, acc[ai][1][m][0] * rs + b10, acc[ai][1][m][1] * rs + b11);
        }
    }
};
struct EpiResid {
    bf16_t* H; float* ss; const float* bias; unsigned char* H8; float descale;
    __device__ __forceinline__ void operator()(AccRef acc, const Unit& u, int wr, int wc, int fr, int fq) const {
        const size_t rowU = (size_t)u.pm * 256 + wr * 64;
        f32x4 b00 = {0.f, 0.f, 0.f, 0.f}, b01 = b00, b10 = b00, b11 = b00;
        if (bias) { const char* bpu = (const char*)(bias + u.pn * 256 + wc * 32); const unsigned bl = (unsigned)(fq * 8) * 4u;
            b00 = *(const f32x4*)(bpu + bl); b01 = *(const f32x4*)(bpu + bl + 16); b10 = *(const f32x4*)(bpu + bl + 512); b11 = *(const f32x4*)(bpu + bl + 528); }
        char* hu = (char*)(H + rowU * 1024 + u.pn * 256 + wc * 32); const unsigned hl = (unsigned)(fr * 1024 + fq * 8) * 2u;
        char* sso = (char*)(ss + rowU * 16 + u.pn * 4 + wc); const unsigned sso_l = (unsigned)(fr * 16) * 4u;
        char* h8u = (char*)(H8 + rowU * 1024 + u.pn * 256 + wc * 32); const unsigned h8l = (unsigned)(fr * 1024 + fq * 8);
        u32x4 hw[8][2];
#pragma unroll
        for (int g = 0; g < 8; ++g) { EPI_G(g); const char* p = hu + hl + rowc * 2048; hw[g][0] = *(const u32x4*)p; hw[g][1] = *(const u32x4*)(p + 256); }
#pragma unroll
        for (int g = 0; g < 8; ++g) { EPI_G(g);
            char* p = hu + hl + rowc * 2048;
            f32x4 h00, h01, h10, h11; unpack8(hw[g][0], h00, h01); unpack8(hw[g][1], h10, h11);
            h00 += acc[ai][0][m][0] * descale + b00; h01 += acc[ai][0][m][1] * descale + b01; h10 += acc[ai][1][m][0] * descale + b10; h11 += acc[ai][1][m][1] * descale + b11;
            store8c(p, h00, h01); store8c(p + 256, h10, h11);
            if (H8) { u32x2 q0, q1; q0.x = pack4_fp8(h00); q0.y = pack4_fp8(h01); q1.x = pack4_fp8(h10); q1.y = pack4_fp8(h11);
                *(u32x2*)(h8u + h8l + rowc * 1024) = q0; *(u32x2*)(h8u + h8l + rowc * 1024 + 128) = q1; }
            float sq = (sq4(h00) + sq4(h01)) + (sq4(h10) + sq4(h11));
            sq = red_fq(sq);
            if (fq == 0) *(float*)(sso + sso_l + rowc * 64) = sq;
        }
    }
};
struct EpiSwiGlu {
    const float* ssh; bf16_t* ACT; int pitch; const int* idx;
    __device__ __forceinline__ void operator()(AccRef acc, const Unit& u, int wr, int wc, int fr, int fq) const {
        const size_t rowU = (size_t)u.pm * 256 + wr * 64;
        const char* ssu = (const char*)(ssh + rowU * 16); const unsigned slo = (unsigned)(fr * 16 + 4 * fq) * 4u;
        char* au = (char*)(ACT + rowU * pitch + u.pn * 128 + wc * 32); const unsigned al = (unsigned)(fr * pitch + fq * 8) * 2u;
        const char* iu = (const char*)(idx + rowU); const unsigned il = (unsigned)fr * 4u;
        f32x4 sv[8];
        if (idx) { int t[8];
#pragma unroll
            for (int g = 0; g < 8; ++g) { EPI_G(g); t[g] = *(const int*)(iu + il + rowc * 4); }
#pragma unroll
            for (int g = 0; g < 8; ++g) { const int tt = t[g] < 0 ? 0 : t[g]; sv[g] = *(const f32x4*)((const char*)ssh + (unsigned)(tt * 16 + 4 * fq) * 4u); }
        } else ss_load8<16>(sv, ssu, slo, fq);
#pragma unroll
        for (int g = 0; g < 8; ++g) { EPI_G(g);
            const float rs = ss_rstd(sv[g], 1.0f / 1024.0f);
            const float c1 = -1.4426950408889634f * rs, c2 = rs * rs;
            const f32x4 a0 = silu_mul_rs(acc[ai][0][m][0], acc[ai][1][m][0], c1, c2), a1 = silu_mul_rs(acc[ai][0][m][1], acc[ai][1][m][1], c1, c2);
            store8c(au + al + (size_t)rowc * pitch * 2, a0, a1);
        }
    }
};
struct EpiSwiGlu8 {
    const float* rsl; unsigned char* ACT; int pitch;
    __device__ __forceinline__ void operator()(AccRef acc, const Unit& u, int wr, int wc, int fr, int fq) const {
        const size_t rowU = (size_t)u.pm * 256 + wr * 64;
        char* au = (char*)(ACT + rowU * pitch + u.pn * 128 + wc * 32); const unsigned al = (unsigned)(fr * pitch + fq * 8);
#pragma unroll
        for (int g = 0; g < 8; ++g) { EPI_G(g);
            f32x4 a0, a1;
#pragma unroll
            for (int e = 0; e < 4; ++e) { const float g0 = acc[ai][0][m][0][e], g1 = acc[ai][0][m][1][e];
                a0[e] = (g0 * acc[ai][1][m][0][e]) * __builtin_amdgcn_rcpf(1.0f + __builtin_amdgcn_exp2f(g0));
                a1[e] = (g1 * acc[ai][1][m][1][e]) * __builtin_amdgcn_rcpf(1.0f + __builtin_amdgcn_exp2f(g1)); }
            u32x2 w; w.x = pack4_fp8(a0); w.y = pack4_fp8(a1);
            *(u32x2*)(au + al + (size_t)rowc * pitch) = w;
        }
    }
};
struct EpiSwiGlu8D {
    const float* ssh; unsigned char* ACT; int pitch;
    __device__ __forceinline__ void operator()(AccRef acc, const Unit& u, int wr, int wc, int fr, int fq) const {
        const size_t rowU = (size_t)u.pm * 256 + wr * 64;
        const char* ssu = (const char*)(ssh + rowU * 16); const unsigned slo = (unsigned)(fr * 16 + 4 * fq) * 4u;
        char* au = (char*)(ACT + rowU * pitch + u.pn * 128 + wc * 32); const unsigned al = (unsigned)(fr * pitch + fq * 8);
        f32x4 sv[8]; ss_load8<16>(sv, ssu, slo, fq);
#pragma unroll
        for (int g = 0; g < 8; ++g) { EPI_G(g);
            const float rs = ss_rstd(sv[g], 1.0f / 1024.0f) * (1.0f / SCALE_GU);
            const float c1 = -1.4426950408889634f * rs, c2 = rs * rs;
            const f32x4 a0 = silu_mul_rs(acc[ai][0][m][0], acc[ai][1][m][0], c1, c2), a1 = silu_mul_rs(acc[ai][0][m][1], acc[ai][1][m][1], c1, c2);
            u32x2 w; w.x = pack4_fp8(a0); w.y = pack4_fp8(a1);
            *(u32x2*)(au + al + (size_t)rowc * pitch) = w;
        }
    }
};
struct EpiMoeDown {
    const bf16_t* Hin; bf16_t* Hout; float* ss; const int* idx; const float* wl; int final_; float descale;
    __device__ __forceinline__ void operator()(AccRef acc, const Unit& u, int wr, int wc, int fr, int fq) const {
        const size_t rowU = (size_t)u.pm * 256 + wr * 64;
        const char* iu = (const char*)(idx + rowU); const char* wu = (const char*)(wl + rowU); const unsigned il = (unsigned)fr * 4u;
        const char* hiu = (const char*)(Hin + u.pn * 256 + wc * 32); char* hou = (char*)(Hout + u.pn * 256 + wc * 32);
        char* sso = (char*)(ss + u.pn * 4 + wc);
        int tk[8]; float wg[8];
#pragma unroll
        for (int g = 0; g < 8; ++g) { EPI_G(g); tk[g] = *(const int*)(iu + il + rowc * 4); wg[g] = *(const float*)(wu + il + rowc * 4); }
        u32x4 hw[8][2];
#pragma unroll
        for (int g = 0; g < 8; ++g) { const int tt = tk[g] < 0 ? 0 : tk[g]; const unsigned ho = (unsigned)(tt * 1024 + fq * 8) * 2u; hw[g][0] = *(const u32x4*)(hiu + ho); hw[g][1] = *(const u32x4*)(hiu + ho + 256); }
#pragma unroll
        for (int g = 0; g < 8; ++g) { EPI_G(g);
            const int tok = tk[g]; const float w = wg[g] * descale;
            float sq = 0.f;
            f32x4 h00, h01, h10, h11; unpack8(hw[g][0], h00, h01); unpack8(hw[g][1], h10, h11);
            h00 += acc[ai][0][m][0] * w; h01 += acc[ai][0][m][1] * w; h10 += acc[ai][1][m][0] * w; h11 += acc[ai][1][m][1] * w;
            if (tok >= 0) {
                const unsigned ho = (unsigned)(tok * 1024 + fq * 8) * 2u;
                store8c(hou + ho, h00, h01); store8c(hou + ho + 256, h10, h11);
                sq = (sq4(h00) + sq4(h01)) + (sq4(h10) + sq4(h11));
            }
            if (final_) { sq = red_fq(sq); if (fq == 0 && tok >= 0) *(float*)(sso + (unsigned)(tok * 16) * 4u) = sq; }
        }
    }
};

namespace att {
#define KSWZ(row, colB) ((row) * 256 + ((colB) ^ (((row) & 7) << 4)))
#define SBAR() __builtin_amdgcn_sched_barrier(0)
__device__ __forceinline__ int v_st(int k, int c) { const int kk = (k & ~0xC) | ((k & 4) << 1) | ((k & 8) >> 1); return ((kk >> 3) * 4 + (c >> 5)) * 512 + ((kk & 7) * 32 + (c & 31)) * 2; }
__device__ __forceinline__ int v_rd_base(int lane) { return ((lane & 3) << 3) | (((lane >> 2) & 3) << 6) | (((lane >> 4) & 1) << 5) | (((lane >> 5) & 1) << 8); }
__device__ __forceinline__ int crow(int r, int hi) { return (r & 3) + 8 * (r >> 2) + 4 * hi; }
#define PK4(P, B_, OUT) do { unsigned a0 = cvtpk(P[B_+0], P[B_+1]), a1 = cvtpk(P[B_+2], P[B_+3]);                          \
        unsigned b0 = cvtpk(P[B_+4], P[B_+5]), b1 = cvtpk(P[B_+6], P[B_+7]);                                             \
        auto r0 = __builtin_amdgcn_permlane32_swap(a0, b0, false, false); auto r1 = __builtin_amdgcn_permlane32_swap(a1, b1, false, false); \
        u32x4 w = {r0[0], r1[0], r0[1], r1[1]}; OUT = __builtin_bit_cast(bf16x8, w); } while (0)
#define TRRD(dst, base, off) asm volatile("ds_read_b64_tr_b16 %0, %1 offset:%2" : "=&v"(dst) : "v"(base), "i"(off) : "memory")
#define MKB(l, h) (bf16x8){l[0], l[1], l[2], l[3], h[0], h[1], h[2], h[3]}
}

__device__ __forceinline__ void glds16_1(const void* sbase, unsigned voff, unsigned ldsaddr) {
    asm volatile("s_mov_b32 m0, %2\n\ts_nop 0\n\tglobal_load_lds_dwordx4 %0, %1" :: "v"(voff), "s"(sbase), "s"(ldsaddr) : "memory"); }
__device__ __forceinline__ void mla_attn_block(const bf16_t* __restrict__ Q, const bf16_t* __restrict__ KV, const bf16_t* __restrict__ KR, bf16_t* __restrict__ O, int b, int h, int qb, LAS char* lds,
                                               bf16x8 (&qr)[12], const bool pre, const int nb, const int nh, const int nqb) {
    using namespace att;
    constexpr float SCALE = 0.07216878364870323f, C2 = 1.4426950408889634f * SCALE, THR = 8.f;
    int tid = threadIdx.x; asm volatile("" : "+v"(tid));
    const int wid = __builtin_amdgcn_readfirstlane(tid >> 6), lane = tid & 63, r32 = lane & 31, hi = lane >> 5;
    LAS char* V_lds = lds; LAS char* K_lds = lds + 49152; LAS char* R_lds = lds + 98304;
    LAS float* wsf = (LAS float*)(lds + 122880) + wid * 64; LAS float* li_l = wsf; LAS float* al_l = wsf + 32;
    const size_t tok0 = (size_t)b * SEQ;
    const int P0 = qb * 256, NT = (P0 + 256) / 64;
    const char* Ku = (const char*)(KV + tok0 * 2048 + h * 256); const char* Ru = (const char*)(KR + tok0 * 64);
    unsigned kof[2], vof[2], rof;
#pragma unroll
    for (int jj = 0; jj < 2; ++jj) { const int j = 2 * wid + jj;
        { const int row = 4 * j + (lane >> 4); kof[jj] = (unsigned)(row * 4096 + ((16 * (lane & 15)) ^ ((row & 7) << 4))); }
        { const int sub = 2 * j + (lane >> 5), kk = (sub >> 2) * 8 + ((lane & 31) >> 2), k = (kk & ~0xC) | ((kk & 4) << 1) | ((kk & 8) >> 1), c = (sub & 3) * 32 + 8 * (lane & 3);
          vof[jj] = (unsigned)(k * 4096 + 256 + c * 2); } }
    { const int row = 8 * wid + (lane >> 3); rof = (unsigned)(row * 128 + ((16 * (lane & 7)) ^ ((row & 7) << 4))); }
    const unsigned ldsK = (unsigned)(uintptr_t)K_lds + (unsigned)(2 * wid) * 1024u, ldsV = (unsigned)(uintptr_t)V_lds + (unsigned)(2 * wid) * 1024u, ldsR = (unsigned)(uintptr_t)R_lds + (unsigned)wid * 1024u;
#define TLOAD(k0, sg) do { const char* ku_ = Ku + (size_t)(k0) * 4096; const char* ru_ = Ru + (size_t)(k0) * 128; \
        glds16_1(ku_, kof[0], ldsK + (sg) * 16384); glds16_1(ku_, kof[1], ldsK + (sg) * 16384 + 1024); \
        glds16_1(ku_, vof[0], ldsV + (sg) * 16384); glds16_1(ku_, vof[1], ldsV + (sg) * 16384 + 1024); \
        glds16_1(ru_, rof, ldsR + (sg) * 8192); } while (0)
    if (!pre) { TLOAD(0, 0); TLOAD(64, 1); }
    asm volatile("s_waitcnt vmcnt(0)" ::: "memory");
    __syncthreads();
    float m_reg = -1e30f, l_reg = 0.f; f32x16 o[4];
#pragma unroll
    for (int d = 0; d < 4; ++d) o[d] = f32x16{};
    const int vb0 = (int)(uintptr_t)V_lds + v_rd_base(lane);
    const int qlo = P0 + wid * 32, qm = qlo + r32 - 4 * hi;
    const int kq0 = KSWZ(r32, (0 * 16 + hi * 8) * 2), kq1 = KSWZ(r32, (1 * 16 + hi * 8) * 2), kq2 = KSWZ(r32, (2 * 16 + hi * 8) * 2), kq3 = KSWZ(r32, (3 * 16 + hi * 8) * 2);
    const int rq_sw = (r32 & 7) << 4;
    bf16x8 pa0, pa1, pa2, pa3;
#define QKT(P0_, P1_, sg) do { P0_ = f32x16{}; P1_ = f32x16{}; \
        { LAS const char* kb = K_lds + (sg) * 16384; \
          _Pragma("unroll") for (int d0 = 0; d0 < 8; ++d0) { const int ko = ((d0 & 3) == 0 ? kq0 : (d0 & 3) == 1 ? kq1 : (d0 & 3) == 2 ? kq2 : kq3) + (d0 >> 2) * 128; \
              const bf16x8 b0 = *(LAS const bf16x8*)(kb + ko), b1 = *(LAS const bf16x8*)(kb + ko + 8192); \
              P0_ = __builtin_amdgcn_mfma_f32_32x32x16_bf16(b0, qr[d0], P0_, 0, 0, 0); P1_ = __builtin_amdgcn_mfma_f32_32x32x16_bf16(b1, qr[d0], P1_, 0, 0, 0); } \
          LAS const char* rb = R_lds + (sg) * 8192 + r32 * 128; \
          _Pragma("unroll") for (int dd = 0; dd < 4; ++dd) { const int ro = ((dd * 16 + hi * 8) * 2) ^ rq_sw; \
              const bf16x8 b0 = *(LAS const bf16x8*)(rb + ro), b1 = *(LAS const bf16x8*)(rb + ro + 4096); \
              P0_ = __builtin_amdgcn_mfma_f32_32x32x16_bf16(b0, qr[8 + dd], P0_, 0, 0, 0); P1_ = __builtin_amdgcn_mfma_f32_32x32x16_bf16(b1, qr[8 + dd], P1_, 0, 0, 0); } } } while (0)
#define MASKT(P0_, P1_, t_) do { const int kbase = (t_) * 64; \
        if (kbase + 63 > qlo) { const float NEG = -__builtin_inff(); const int dq = qm - kbase; \
            _Pragma("unroll") for (int r = 0; r < 16; ++r) { const int c = (r & 3) + 8 * (r >> 2); if (dq - c < 0) P0_[r] = NEG; if (dq - c - 32 < 0) P1_[r] = NEG; } } } while (0)
    float pmax, mnL, ps, alv;
#define SMXC(c, X0_, X1_) do { \
        if ((c) == 0) { pmax = X0_[0]; _Pragma("unroll") for (int r = 1; r < 16; ++r) pmax = fmaxf(pmax, X0_[r]); } \
        else if ((c) == 1) { _Pragma("unroll") for (int r = 0; r < 16; ++r) pmax = fmaxf(pmax, X1_[r]); \
            { auto rr = __builtin_amdgcn_permlane32_swap(__float_as_uint(pmax), __float_as_uint(pmax), false, false); pmax = fmaxf(__uint_as_float(rr[0]), __uint_as_float(rr[1])); } \
            const bool keep = __all((pmax - m_reg) * SCALE <= THR); const float mn = keep ? m_reg : fmaxf(m_reg, pmax); \
            alv = __builtin_amdgcn_exp2f((m_reg - mn) * C2); m_reg = mn; mnL = -mn * C2; ps = 0.f; } \
        else if ((c) < 10) { _Pragma("unroll") for (int r = 2 * ((c) - 2); r < 2 * ((c) - 2) + 2; ++r) { \
                X0_[r] = __builtin_amdgcn_exp2f(fmaf(X0_[r], C2, mnL)); X1_[r] = __builtin_amdgcn_exp2f(fmaf(X1_[r], C2, mnL)); ps += X0_[r]; ps += X1_[r]; } } \
        else if ((c) == 10) { { auto rr = __builtin_amdgcn_permlane32_swap(__float_as_uint(ps), __float_as_uint(ps), false, false); ps = __uint_as_float(rr[0]) + __uint_as_float(rr[1]); } \
            l_reg = l_reg * alv + ps; PK4(X0_, 0, pa0); PK4(X0_, 8, pa1); } \
        else { PK4(X1_, 0, pa2); PK4(X1_, 8, pa3); } } while (0)
#define SMXALL(X0_, X1_) do { _Pragma("unroll") for (int c_ = 0; c_ < 12; ++c_) SMXC(c_, X0_, X1_); } while (0)
#define RESCALE(alpha_) do { if (__any(alpha_ < 1.f)) { if (hi == 0) al_l[r32] = alpha_; asm volatile("s_waitcnt lgkmcnt(0)" ::: "memory"); \
            _Pragma("unroll") for (int d_ = 0; d_ < 4; ++d_) _Pragma("unroll") for (int r = 0; r < 16; ++r) o[d_][r] *= al_l[crow(r, hi)]; } } while (0)
#define KFRAG(d, sg, f0, f1) do { if ((d) < 8) { const int ko = (((d) & 3) == 0 ? kq0 : ((d) & 3) == 1 ? kq1 : ((d) & 3) == 2 ? kq2 : kq3) + ((d) >> 2) * 128; LAS const char* kb_ = K_lds + (sg) * 16384; \
            f0 = *(LAS const bf16x8*)(kb_ + ko); f1 = *(LAS const bf16x8*)(kb_ + ko + 8192); } \
        else { const int ro = ((((d) - 8) * 16 + hi * 8) * 2) ^ rq_sw; LAS const char* rb_ = R_lds + (sg) * 8192 + r32 * 128; f0 = *(LAS const bf16x8*)(rb_ + ro); f1 = *(LAS const bf16x8*)(rb_ + ro + 4096); } } while (0)
#define QK_SMX(Y0_, Y1_, sg, X0_, X1_) do { Y0_ = f32x16{}; Y1_ = f32x16{}; bf16x8 cf0, cf1; KFRAG(0, sg, cf0, cf1); \
        _Pragma("unroll") for (int d = 0; d < 12; ++d) { bf16x8 nf0 = cf0, nf1 = cf1; if (d + 1 < 12) KFRAG(d + 1, sg, nf0, nf1); \
            Y0_ = __builtin_amdgcn_mfma_f32_32x32x16_bf16(cf0, qr[d], Y0_, 0, 0, 0); Y1_ = __builtin_amdgcn_mfma_f32_32x32x16_bf16(cf1, qr[d], Y1_, 0, 0, 0); \
            SMXC(d, X0_, X1_); SBAR(); cf0 = nf0; cf1 = nf1; } } while (0)
#define PV_D0(vb, d0) do { s16x4 l0, l1, l2, l3, h0, h1, h2, h3; constexpr int b_ = (d0) * 512; \
            TRRD(l0, vb, b_); TRRD(h0, vb, b_ + 2048); TRRD(l1, vb, b_ + 4096); TRRD(h1, vb, b_ + 6144); TRRD(l2, vb, b_ + 8192); TRRD(h2, vb, b_ + 10240); TRRD(l3, vb, b_ + 12288); TRRD(h3, vb, b_ + 14336); \
            asm volatile("s_waitcnt lgkmcnt(0)" ::: "memory"); SBAR(); \
            o[d0] = __builtin_amdgcn_mfma_f32_32x32x16_bf16(pa0, MKB(l0, h0), o[d0], 0, 0, 0); o[d0] = __builtin_amdgcn_mfma_f32_32x32x16_bf16(pa1, MKB(l1, h1), o[d0], 0, 0, 0); \
            o[d0] = __builtin_amdgcn_mfma_f32_32x32x16_bf16(pa2, MKB(l2, h2), o[d0], 0, 0, 0); o[d0] = __builtin_amdgcn_mfma_f32_32x32x16_bf16(pa3, MKB(l3, h3), o[d0], 0, 0, 0); } while (0)
#define PVT(sg) do { const int vb_ = vb0 + (sg) * 16384; PV_D0(vb_, 0); PV_D0(vb_, 1); PV_D0(vb_, 2); PV_D0(vb_, 3); } while (0)
#define ENDSTEP() do { asm volatile("s_waitcnt vmcnt(0)" ::: "memory"); __syncthreads(); } while (0)
    f32x16 pA0, pA1, pB0, pB1;
    QKT(pA0, pA1, 0);
    int sg = 0;
#pragma unroll 1
    for (int t = 0; t < NT; t += 2) {
        const int s1 = sg == 2 ? 0 : sg + 1, s2 = s1 == 2 ? 0 : s1 + 1;
        if (t + 2 < NT) TLOAD((t + 2) * 64, s2);
        MASKT(pA0, pA1, t); SBAR();
        QK_SMX(pB0, pB1, s1, pA0, pA1);
        RESCALE(alv); PVT(sg);
        ENDSTEP();
        if (t + 3 < NT) TLOAD((t + 3) * 64, sg);
        MASKT(pB0, pB1, t + 1); SBAR();
        if (t + 2 < NT) QK_SMX(pA0, pA1, s2, pB0, pB1); else SMXALL(pB0, pB1);
        RESCALE(alv); PVT(s1);
        ENDSTEP();
        sg = s2;
    }
    if (nqb >= 0) {
        const size_t ntok0 = (size_t)nb * SEQ;
        const char* KuN = (const char*)(KV + ntok0 * 2048 + nh * 256); const char* RuN = (const char*)(KR + ntok0 * 64);
#define TLOADN(k0, sg_) do { const char* ku_ = KuN + (size_t)(k0) * 4096; const char* ru_ = RuN + (size_t)(k0) * 128; \
        glds16_1(ku_, kof[0], ldsK + (sg_) * 16384); glds16_1(ku_, kof[1], ldsK + (sg_) * 16384 + 1024); \
        glds16_1(ku_, vof[0], ldsV + (sg_) * 16384); glds16_1(ku_, vof[1], ldsV + (sg_) * 16384 + 1024); \
        glds16_1(ru_, rof, ldsR + (sg_) * 8192); } while (0)
        TLOADN(0, 0); TLOADN(64, 1);
#undef TLOADN
        const char* QuN = (const char*)(Q + (ntok0 + nqb * 256 + wid * 32) * 1536 + nh * 192); const unsigned qoN = (unsigned)(r32 * 1536 + hi * 8) * 2u;
#pragma unroll
        for (int d0 = 0; d0 < 12; ++d0) qr[d0] = *(const bf16x8*)(QuN + qoN + d0 * 32);
    }
#undef TLOAD
#undef QKT
#undef SMXC
#undef SMXALL
#undef KFRAG
#undef QK_SMX
#undef MASKT
#undef RESCALE
#undef PV_D0
#undef PVT
#undef ENDSTEP
    if (hi == 0) li_l[r32] = l_reg; asm volatile("s_waitcnt lgkmcnt(0)" ::: "memory");
    char* Ou = (char*)(O + (tok0 + P0 + wid * 32) * 1024 + h * 128); const unsigned oo = (unsigned)(4 * hi * 1024 + r32) * 2u;
    unsigned char* O8u = (unsigned char*)O + (tok0 + P0 + wid * 32) * 1024 + h * 128; const unsigned oo8 = (unsigned)(4 * hi * 1024 + r32);
#pragma unroll
    for (int r = 0; r < 16; ++r) { const float rl = __builtin_amdgcn_rcpf(li_l[crow(r, hi)]) * (F8_WOM ? SCALE_O : 1.0f);
#pragma unroll
        for (int d0 = 0; d0 < 4; ++d0) { const float v = o[d0][r] * rl; const float vn = __shfl_xor(v, 1);
            if (F8_WOM) { const float v2 = __shfl_xor(v, 2), v3 = __shfl_xor(v, 3);
                if ((r32 & 3) == 0) *(unsigned*)((char*)O8u + oo8 + (((r & 3) + 8 * (r >> 2)) * 1024 + d0 * 32)) = pack4_fp8((f32x4){v, vn, v2, v3}); }
            else if ((r32 & 1) == 0) *(unsigned*)(Ou + oo + (((r & 3) + 8 * (r >> 2)) * 1024 + d0 * 32) * 2) = cvtpk(v, vn); } }
    __syncthreads();
}

__device__ __forceinline__ void swa_attn_unit(const bf16_t* __restrict__ Q, const bf16_t* __restrict__ KVB, bf16_t* __restrict__ O, const int* __restrict__ positions, const float* __restrict__ sinks,
                                              int b, int ib, LAS char* lds, LAS int* posl, LAS const float* biasd, LAS float* wscr) {
    using namespace att;
    int tid = threadIdx.x; asm volatile("" : "+v"(tid));
    const int wid = __builtin_amdgcn_readfirstlane(tid >> 6), lane = tid & 63, r32 = lane & 31, hi = lane >> 5;
    LAS char* V_lds = lds; LAS char* K_lds = lds + 65536;
    LAS float* li_l = wscr + wid * 64;
    const size_t tok0 = (size_t)b * SEQ + (size_t)ib * 128;
    { const int sr = tid >> 4, sc = (tid & 15) * 8;
#pragma unroll
      for (int tl = 0; tl < 4; ++tl)
#pragma unroll
        for (int hf = 0; hf < 2; ++hf) { const int row = hf * 32 + sr; bf16x8 kx = bf16x8{}, vx = bf16x8{};
            if (ib > 0 || tl >= 2) { const bf16_t* g = KVB + (tok0 - 128 + tl * 64 + row) * 256 + sc; kx = *(const bf16x8*)g; vx = *(const bf16x8*)(g + 128); }
            *(LAS bf16x8*)(K_lds + tl * 16384 + KSWZ(row, sc * 2)) = kx; *(LAS bf16x8*)(V_lds + tl * 16384 + v_st(row, sc)) = vx; }
      if (tid < 128) posl[tid] = positions[tok0 + tid];
      if (tid < 256) posl[128 + tid] = (ib > 0 || tid >= 128) ? positions[tok0 - 128 + tid] : 0; }
    __syncthreads();
    const int kvh = wid >> 2;
    for (int it = 0; it < 8; ++it) {
        const int hq = 2 * wid + (it >> 2), s = it & 3;
        bf16x8 qr[4];
        { const bf16_t* Qw = Q + (tok0 + 32 * s + r32) * 1024 + hq * 64 + hi * 8;
#pragma unroll
          for (int d0 = 0; d0 < 4; ++d0) qr[d0] = *(const bf16x8*)(Qw + d0 * 16); }
        f32x16 p[5];
        { LAS const char* kb = K_lds + s * 8192 + kvh * 128;
          const int k0 = KSWZ(r32, (0 * 16 + hi * 8) * 2), k1 = KSWZ(r32, (1 * 16 + hi * 8) * 2), k2 = KSWZ(r32, (2 * 16 + hi * 8) * 2), k3 = KSWZ(r32, (3 * 16 + hi * 8) * 2);
#pragma unroll
          for (int jj = 0; jj < 5; ++jj) { p[jj] = f32x16{};
#pragma unroll
              for (int d0 = 0; d0 < 4; ++d0) { const int ko = (d0 == 0 ? k0 : d0 == 1 ? k1 : d0 == 2 ? k2 : k3) + jj * 8192;
                  p[jj] = __builtin_amdgcn_mfma_f32_32x32x16_bf16(*(LAS const bf16x8*)(kb + ko), qr[d0], p[jj], 0, 0, 0); } } }
        const float sink = sinks[hq];
        const int qp = posl[32 * s + r32];
        LAS const float* bd = biasd + hq * 132;
        const float NEG = -__builtin_inff();
        float mx = sink;
#pragma unroll
        for (int jj = 0; jj < 5; ++jj) {
            if (ib > 0 || s + jj >= 4) {
                float bv[16];
#pragma unroll
                for (int g = 0; g < 4; ++g) {
                    const i32x4 kp4 = *(LAS const i32x4*)(posl + 128 + 32 * (s + jj) + 8 * g + 4 * hi);
#pragma unroll
                    for (int e = 0; e < 4; ++e) { int dist = qp - kp4[e]; dist = dist < 0 ? 0 : (dist > 128 ? 128 : dist); bv[4 * g + e] = bd[dist]; } }
#pragma unroll
                for (int r = 0; r < 16; ++r) { const int rel = 128 + r32 - 32 * jj - (8 * (r >> 2) + 4 * hi + (r & 3));
                    float v = fmaf(p[jj][r], 0.125f, bv[r]);
                    if (jj == 0) v = rel < 128 ? v : NEG;
                    if (jj == 4) v = rel >= 0 ? v : NEG;
                    p[jj][r] = v; mx = fmaxf(mx, v); }
            } else {
#pragma unroll
                for (int r = 0; r < 16; ++r) p[jj][r] = NEG;
            }
        }
        { auto rr = __builtin_amdgcn_permlane32_swap(__float_as_uint(mx), __float_as_uint(mx), false, false); mx = fmaxf(__uint_as_float(rr[0]), __uint_as_float(rr[1])); }
        float ps = 0.f; const float mL = -mx * 1.4426950408889634f;
#pragma unroll
        for (int jj = 0; jj < 5; ++jj)
#pragma unroll
            for (int r = 0; r < 16; ++r) { p[jj][r] = __builtin_amdgcn_exp2f(fmaf(p[jj][r], 1.4426950408889634f, mL)); ps += p[jj][r]; }
        { auto rr = __builtin_amdgcn_permlane32_swap(__float_as_uint(ps), __float_as_uint(ps), false, false); ps = __uint_as_float(rr[0]) + __uint_as_float(rr[1]); }
        ps += __builtin_amdgcn_exp2f(fmaf(sink, 1.4426950408889634f, mL));
        if (hi == 0) li_l[r32] = ps;
        f32x16 o0 = f32x16{}, o1 = f32x16{};
        { const int vb = (int)(uintptr_t)V_lds + v_rd_base(lane) + s * 8192 + kvh * 1024;
#pragma unroll
          for (int jj = 0; jj < 5; ++jj) { bf16x8 pa, pb; PK4(p[jj], 0, pa); PK4(p[jj], 8, pb);
              s16x4 l0, h0, l1, h1, l2, h2, l3, h3;
              switch (jj) {
#define SWA_RD(J) TRRD(l0, vb, (J) * 8192); TRRD(h0, vb, (J) * 8192 + 2048); TRRD(l1, vb, (J) * 8192 + 4096); TRRD(h1, vb, (J) * 8192 + 6144); \
                  TRRD(l2, vb, (J) * 8192 + 512); TRRD(h2, vb, (J) * 8192 + 512 + 2048); TRRD(l3, vb, (J) * 8192 + 512 + 4096); TRRD(h3, vb, (J) * 8192 + 512 + 6144)
                  case 0: SWA_RD(0); break; case 1: SWA_RD(1); break; case 2: SWA_RD(2); break; case 3: SWA_RD(3); break; default: SWA_RD(4); break;
#undef SWA_RD
              }
              asm volatile("s_waitcnt lgkmcnt(0)" ::: "memory"); SBAR();
              o0 = __builtin_amdgcn_mfma_f32_32x32x16_bf16(pa, MKB(l0, h0), o0, 0, 0, 0); o0 = __builtin_amdgcn_mfma_f32_32x32x16_bf16(pb, MKB(l1, h1), o0, 0, 0, 0);
              o1 = __builtin_amdgcn_mfma_f32_32x32x16_bf16(pa, MKB(l2, h2), o1, 0, 0, 0); o1 = __builtin_amdgcn_mfma_f32_32x32x16_bf16(pb, MKB(l3, h3), o1, 0, 0, 0); } }
        asm volatile("s_waitcnt lgkmcnt(0)" ::: "memory");
        bf16_t* Ow = O + (tok0 + 32 * s) * 1024 + hq * 64;
#pragma unroll
        for (int r = 0; r < 16; ++r) { const int orow = crow(r, hi); const float rl = __builtin_amdgcn_rcpf(li_l[orow]) * (F8_WOS ? SCALE_O : 1.0f);
            const float v0 = o0[r] * rl, v1 = o1[r] * rl; const float v0n = __shfl_xor(v0, 1), v1n = __shfl_xor(v1, 1);
            if (F8_WOS) { const float v02 = __shfl_xor(v0, 2), v03 = __shfl_xor(v0, 3), v12 = __shfl_xor(v1, 2), v13 = __shfl_xor(v1, 3);
                if ((r32 & 3) == 0) { unsigned char* o8 = (unsigned char*)O + (tok0 + 32 * s + orow) * 1024 + hq * 64 + r32;
                    *(unsigned*)o8 = pack4_fp8((f32x4){v0, v0n, v02, v03}); *(unsigned*)(o8 + 32) = pack4_fp8((f32x4){v1, v1n, v12, v13}); } }
            else if ((r32 & 1) == 0) { *(unsigned*)(Ow + (size_t)orow * 1024 + r32) = cvtpk(v0, v0n); *(unsigned*)(Ow + (size_t)orow * 1024 + 32 + r32) = cvtpk(v1, v1n); } }
        asm volatile("s_waitcnt lgkmcnt(0)" ::: "memory");
    }
    __syncthreads();
}

#define XB_TMO      128
#define XB_XCNT(j)  (256  + 64 * (j))
#define XB_XSUB(j)  (1280 + 64 * (j))
#define XB_XGEN(j)  (2304 + 64 * (j))
#define XB_TOP      3328
#define XB_TOPGEN   3392
#define XCD_BAR_WORDS 3456
#define XB_SPIN_CAP (1u << 22)
__device__ __forceinline__ unsigned xb_ld(unsigned* p)              { return __hip_atomic_load(p, __ATOMIC_RELAXED, __HIP_MEMORY_SCOPE_AGENT); }
__device__ __forceinline__ unsigned xb_add(unsigned* p, unsigned v) { return __hip_atomic_fetch_add(p, v, __ATOMIC_RELAXED, __HIP_MEMORY_SCOPE_AGENT); }
__device__ __forceinline__ unsigned xb_xcc_id() { return (unsigned)__builtin_amdgcn_s_getreg((3 << 11) | 20) & 0xFu; }
#define XB_SPIN(cond, bar) do { unsigned _sp = 0; while (cond) { __builtin_amdgcn_s_sleep(1); \
    if ((++_sp & 255u) == 0u) { if (xb_ld(&(bar)[XB_TMO])) break; if (_sp > XB_SPIN_CAP) { atomicAdd(&(bar)[XB_TMO], 1u); break; } } } } while (0)
struct XcdBarrier { unsigned* bar; unsigned x; volatile LAS unsigned* st; };
__device__ __forceinline__ XcdBarrier xcd_barrier_post(unsigned* bar, volatile LAS unsigned* st) {
    XcdBarrier b; b.bar = bar; b.x = xb_xcc_id(); b.st = st;
    if (threadIdx.x == 0) (void)xb_add(&bar[XB_XCNT(b.x)], 1u);
    return b;
}
__device__ __forceinline__ void xcd_barrier_complete(unsigned* bar, unsigned x, unsigned& nloc, unsigned& nx) {
    const unsigned G = gridDim.x * gridDim.y * gridDim.z;
    unsigned sum, cnt, mine, sp = 0u;
    for (;;) {
        sum = 0u; cnt = 0u; mine = 0u;
#pragma unroll
        for (unsigned j = 0; j < 16; ++j) { const unsigned c = xb_ld(&bar[XB_XCNT(j)]); sum += c; cnt += (c > 0u) ? 1u : 0u; mine = (j == x) ? c : mine; }
        if (sum == G) break;
        __builtin_amdgcn_s_sleep(1);
        if ((++sp & 255u) == 0u) { if (xb_ld(&bar[XB_TMO])) break; if (sp > XB_SPIN_CAP) { atomicAdd(&bar[XB_TMO], 1u); break; } }
    }
    nloc = mine > 0u ? mine : 1u; nx = cnt > 0u ? cnt : 1u;
}
__device__ __forceinline__ void xcd_barrier(const XcdBarrier& b) {
    asm volatile("s_waitcnt vmcnt(0)" ::: "memory");
    __syncthreads();
    if (threadIdx.x == 0) {
        unsigned* bar = b.bar;
        __builtin_amdgcn_s_waitcnt(0);
        unsigned nloc = b.st[0], nx = b.st[1];
        if (nloc == 0u) { xcd_barrier_complete(bar, b.x, nloc, nx); b.st[0] = nloc; b.st[1] = nx; }
        const unsigned old = xb_add(&bar[XB_XSUB(b.x)], 1u);
        const unsigned gen = old / nloc;
        if (old + 1u == (gen + 1u) * nloc) {
            __builtin_amdgcn_fence(__ATOMIC_RELEASE, "agent");
            asm volatile("s_waitcnt vmcnt(0)" ::: "memory");
            const unsigned og = xb_add(&bar[XB_TOP], 1u);
            const unsigned tg = og / nx;
            if (og + 1u == (tg + 1u) * nx) xb_add(&bar[XB_TOPGEN], 1u);
            else XB_SPIN(xb_ld(&bar[XB_TOPGEN]) == tg, bar);
            __builtin_amdgcn_fence(__ATOMIC_ACQUIRE, "agent");
            xb_add(&bar[XB_XGEN(b.x)], 1u);
            asm volatile("s_waitcnt vmcnt(0)" ::: "memory");
        } else {
            XB_SPIN(xb_ld(&bar[XB_XGEN(b.x)]) == gen, bar);
            __builtin_amdgcn_fence(__ATOMIC_ACQUIRE, "agent");
            asm volatile("s_waitcnt vmcnt(0)" ::: "memory");
        }
    }
    __syncthreads();
}

__device__ __forceinline__ void cvt_item(const float* __restrict__ W, int K, int N, int sn0, const float* __restrict__ gain, bf16_t* __restrict__ dst, int dn0, int k0, LAS float* scr, int lane) {
    if (sn0 >= 0) {
        f32x4 v[8];
#pragma unroll
        for (int i = 0; i < 8; ++i) { const int kk = 8 * i + (lane >> 3); v[i] = *(const f32x4*)(W + (size_t)(k0 + kk) * N + sn0 + 4 * (lane & 7)); }
#pragma unroll
        for (int i = 0; i < 8; ++i) { const int kk = 8 * i + (lane >> 3); const float gk = gain ? gain[k0 + kk] : 1.0f; LAS float* d = scr + kk * 33 + 4 * (lane & 7);
            d[0] = v[i][0] * gk; d[1] = v[i][1] * gk; d[2] = v[i][2] * gk; d[3] = v[i][3] * gk; }
    } else {
#pragma unroll 8
        for (int i = 0; i < 32; ++i) { const int kk = 2 * i + (lane >> 5); scr[kk * 33 + (lane & 31)] = 0.f; }
    }
    asm volatile("s_waitcnt lgkmcnt(0)" ::: "memory");
    const int c = lane & 7;
#pragma unroll
    for (int j = 0; j < 4; ++j) { const int n = (lane >> 3) + 8 * j; const LAS float* s = scr + (8 * c) * 33 + n;
        u32x4 o; o.x = cvtpk(s[0 * 33], s[1 * 33]); o.y = cvtpk(s[2 * 33], s[3 * 33]); o.z = cvtpk(s[4 * 33], s[5 * 33]); o.w = cvtpk(s[6 * 33], s[7 * 33]);
        *(u32x4*)(dst + (size_t)(dn0 + n) * K + k0 + 8 * c) = o; }
    asm volatile("s_waitcnt lgkmcnt(0)" ::: "memory");
}

__device__ __forceinline__ void cvt_item8(const float* __restrict__ W, int K, int N, int sn0, const float* __restrict__ gain, float scale, unsigned char* __restrict__ dst, int dn0, int k0, LAS float* scr, int lane) {
    { f32x4 v[8];
#pragma unroll
      for (int i = 0; i < 8; ++i) { const int kk = 8 * i + (lane >> 3); v[i] = *(const f32x4*)(W + (size_t)(k0 + kk) * N + sn0 + 4 * (lane & 7)); }
#pragma unroll
      for (int i = 0; i < 8; ++i) { const int kk = 8 * i + (lane >> 3); const float gk = gain ? gain[k0 + kk] * scale : scale; LAS float* d = scr + kk * 33 + 4 * (lane & 7);
          d[0] = v[i][0] * gk; d[1] = v[i][1] * gk; d[2] = v[i][2] * gk; d[3] = v[i][3] * gk; } }
    asm volatile("s_waitcnt lgkmcnt(0)" ::: "memory");
    const int n = lane >> 1, hf = lane & 1; const LAS float* sp = scr + (32 * hf) * 33 + n;
    u32x4 o0, o1;
#pragma unroll
    for (int q = 0; q < 4; ++q) { f32x4 v; v[0] = sp[(4 * q + 0) * 33]; v[1] = sp[(4 * q + 1) * 33]; v[2] = sp[(4 * q + 2) * 33]; v[3] = sp[(4 * q + 3) * 33]; o0[q] = pack4_fp8(v); }
#pragma unroll
    for (int q = 0; q < 4; ++q) { f32x4 v; v[0] = sp[(16 + 4 * q + 0) * 33]; v[1] = sp[(16 + 4 * q + 1) * 33]; v[2] = sp[(16 + 4 * q + 2) * 33]; v[3] = sp[(16 + 4 * q + 3) * 33]; o1[q] = pack4_fp8(v); }
    unsigned char* p = dst + (size_t)(dn0 + n) * K + k0 + 32 * hf;
    *(u32x4*)p = o0; *(u32x4*)(p + 16) = o1;
    asm volatile("s_waitcnt lgkmcnt(0)" ::: "memory");
}

struct Args { const void* in[27]; float* out; unsigned char* ws; int ph_lo, ph_hi; };

__global__ void __launch_bounds__(512, 2) yoco_fwd(Args args) {
    extern __shared__ __attribute__((aligned(16))) unsigned char lds_raw[];
    LAS unsigned char* lds = (LAS unsigned char*)lds_raw;
    volatile LAS unsigned* MISC = (volatile LAS unsigned*)(lds + MISC_OFF);
    const int tid0 = threadIdx.x;
#define PH_TID int tid = threadIdx.x; asm volatile("" : "+v"(tid)); const int lane = tid & 63, wave = __builtin_amdgcn_readfirstlane(tid >> 6); const int gw = vcu * 8 + wave; (void)lane; (void)gw
    const int G = gridDim.x, bx = blockIdx.x;
    const int vcu = (G % 8 == 0) ? (bx % 8) * (G / 8) + bx / 8 : bx;
    unsigned char* ws = args.ws;
    unsigned* ctl = (unsigned*)(ws + WS_CTL);
    for (int u = tid0; u < (LDS_BYTES - LDSCTL_OFF) / 4; u += 512) ((LAS unsigned*)(lds + LDSCTL_OFF))[u] = 0u;
    __syncthreads();
    XcdBarrier bar; bar.bar = ctl + CW_BAR; bar.x = 0; bar.st = nullptr;
    if (!MK_PER_PHASE) bar = xcd_barrier_post(ctl + CW_BAR, MISC + 8);
    const int lo = args.ph_lo, hi = args.ph_hi;
#ifndef PH_MASK
#define PH_MASK 0xffffff
#endif
#define PHE(bit) ((PH_MASK >> (bit)) & 1)
#define IN(k) (lo <= (k) && (k) < hi)
#define GRID_BAR(k) do { if (!MK_PER_PHASE && hi > (k) + 1) xcd_barrier(bar); } while (0)

#define x_in ((const float*)args.in[0])
#define positions ((const int*)args.in[1])
#define mla_w_in ((const float*)args.in[2])
#define mla_g_q ((const float*)args.in[3])
#define mla_g_kv ((const float*)args.in[4])
#define mla_w_uq ((const float*)args.in[5])
#define mla_w_ukv ((const float*)args.in[6])
#define mla_w_o ((const float*)args.in[7])
#define kv_g ((const float*)args.in[8])
#define kv_w ((const float*)args.in[9])
#define kv_b ((const float*)args.in[10])
#define swa_w_q ((const float*)args.in[11])
#define swa_b_q ((const float*)args.in[12])
#define swa_sinks ((const float*)args.in[13])
#define swa_w_o ((const float*)args.in[14])
#define swa_b_o ((const float*)args.in[15])
#define rel_bias ((const float*)args.in[16])
#define g_attn ((const float*)args.in[17])
#define g_ffn ((const float*)args.in[18])
#define ffn_w_gate ((const float*)args.in[19])
#define ffn_w_up ((const float*)args.in[20])
#define ffn_w_down ((const float*)args.in[21])
#define moe_w_router ((const float*)args.in[22])
#define moe_w_gate ((const float*)args.in[23])
#define moe_w_up ((const float*)args.in[24])
#define moe_w_down ((const float*)args.in[25])
#define g_final ((const float*)args.in[26])
#define hA ((bf16_t*)(ws + WS_H))
#define ssh ((float*)(ws + WS_SS))
#define KVB ((bf16_t*)(ws + WS_KVB))
#define arena (ws + WS_ARENA)
#define rt (ws + WS_ROUTE)
#define CQ ((bf16_t*)(arena + AR_CQ))
#define CKV ((bf16_t*)(arena + AR_CKV))
#define KRb ((bf16_t*)(arena + AR_KR))
#define Qm ((bf16_t*)(arena + AR_Q))
#define Om ((bf16_t*)(arena + AR_O))
#define cs ((float*)(arena + AR_CS))
#define sslat ((float*)(arena + AR_SSLAT))
#define hA8 (arena + AR_H8)
#define ACT8 (arena + AR_ACT)
#define ACT ((bf16_t*)(arena + AR_ACT))
#define Qs ((bf16_t*)(arena + AR_SQ))
#define Os ((bf16_t*)(arena + AR_SO))
#define KVm ((bf16_t*)args.out)
#define hB ((bf16_t*)args.out)
#define tok_e ((int*)(rt + RT_TOKE))
#define tok_w ((float*)(rt + RT_TOKW))
#define tok_rank ((int*)(rt + RT_RANK))
#define cnts ((int*)(rt + RT_CNT))
#define pcnts ((int*)(rt + RT_PCNT))
#define idxs ((int*)(rt + RT_IDX))
#define wls ((float*)(rt + RT_WL))
#define texp_g ((int*)(rt + RT_TEXP))
#define rsls ((float*)(rt + RT_RSL))
    const int NGW = G * 8;

    if (PHE(0) && IN(0)) {
        PH_TID;
        LAS float* scr = (LAS float*)(lds + wave * 16384);
        int base = 0;
#define CVT_LOOP(NITEMS, ...) do { const int n_ = (NITEMS); int st_ = (gw - base) % NGW; if (st_ < 0) st_ += NGW; for (int it = st_; it < n_; it += NGW) { __VA_ARGS__ } base = (base + n_) % NGW; } while (0)
        for (int a = 0; a < 2; ++a) {
            CVT_LOOP(24 * 16, { const int g = it / 16, kb = it % 16; int sn0;
                if (g < 8) sn0 = 32 * g; else if (g == 8) sn0 = 640; else if (g < 12) sn0 = 256 + 32 * (g - 9); else if (g == 12) sn0 = 672; else if (g == 13) sn0 = 352; else if (g < 16) sn0 = -1; else sn0 = 384 + 32 * (g - 16);
                cvt_item(mla_w_in + (size_t)a * 1024 * LATN, 1024, LATN, sn0, g_attn + a * 1024, (bf16_t*)(ws + WS_WIN + a * SZ_WIN), 32 * g, 64 * kb, scr, lane); });
            CVT_LOOP(48 * 6, { const int g = it / 6, kb = it % 6; int sn0;
                if (g < 32) sn0 = (g >> 2) * 192 + 32 * (g & 3); else { const int gg = g - 32, tile = gg >> 3, half = (gg & 7) >> 2, hh = gg & 3; sn0 = (tile * 4 + hh) * 192 + 128 + 32 * half; }
                cvt_item(mla_w_uq + (size_t)a * 384 * 1536, 384, 1536, sn0, mla_g_q + a * 384, (bf16_t*)(ws + WS_WUQ + a * SZ_WUQ), 32 * g, 64 * kb, scr, lane); });
            CVT_LOOP(64 * 4, { const int g = it / 4, kb = it % 4;
                cvt_item(mla_w_ukv + (size_t)a * 256 * 2048, 256, 2048, 32 * g, mla_g_kv + a * 256, (bf16_t*)(ws + WS_WUKV + a * SZ_WUKV), 32 * g, 64 * kb, scr, lane); });
            CVT_LOOP(32 * 16, { const int g = it / 16, kb = it % 16;
                if (F8_WOM) cvt_item8(mla_w_o + (size_t)a * 1024 * 1024, 1024, 1024, 32 * g, nullptr, SCALE_GU, ws + WS_WOM + a * SZ_WO, 32 * g, 64 * kb, scr, lane);
                else cvt_item(mla_w_o + (size_t)a * 1024 * 1024, 1024, 1024, 32 * g, nullptr, (bf16_t*)(ws + WS_WOM + a * SZ_WO), 32 * g, 64 * kb, scr, lane); });
            CVT_LOOP((a == 0 ? 40 : 32) * 16, { const int g = it / 16, kb = it % 16;
                if (g < 32) cvt_item(swa_w_q + (size_t)a * 1024 * 1024, 1024, 1024, 32 * g, g_attn + (2 + a) * 1024, (bf16_t*)(ws + WS_WQKV + a * SZ_WQKV), 32 * g, 64 * kb, scr, lane);
                else cvt_item(kv_w, 1024, 256, 32 * (g - 32), kv_g, (bf16_t*)(ws + WS_WQKV + a * SZ_WQKV), 32 * g, 64 * kb, scr, lane); });
            CVT_LOOP(32 * 16, { const int g = it / 16, kb = it % 16;
                if (F8_WOS) cvt_item8(swa_w_o + (size_t)a * 1024 * 1024, 1024, 1024, 32 * g, nullptr, SCALE_GU, ws + WS_WOS + a * SZ_WO, 32 * g, 64 * kb, scr, lane);
                else cvt_item(swa_w_o + (size_t)a * 1024 * 1024, 1024, 1024, 32 * g, nullptr, (bf16_t*)(ws + WS_WOS + a * SZ_WO), 32 * g, 64 * kb, scr, lane); });
            CVT_LOOP(176 * 16, { const int g = it / 16, kb = it % 16; const int pn = g >> 3, r = g & 7;
                const float* Wsrc = (r < 4 ? ffn_w_gate : ffn_w_up) + (size_t)a * 1024 * DFF;
                if (F8_D1 && a == 1) cvt_item8(Wsrc, 1024, DFF, 128 * pn + 32 * (r & 3), g_ffn + (2 * a) * 1024, SCALE_GU, ws + WS_WGUD + a * SZ_WGU_D, 32 * g, 64 * kb, scr, lane);
                else cvt_item(Wsrc, 1024, DFF, 128 * pn + 32 * (r & 3), g_ffn + (2 * a) * 1024, (bf16_t*)(ws + WS_WGUD + a * SZ_WGU_D), 32 * g, 64 * kb, scr, lane); });
            CVT_LOOP(32 * 44, { const int g = it / 44, kb = it % 44;
                if (F8_D1 && a == 1) cvt_item8(ffn_w_down + (size_t)a * DFF * 1024, DFF, 1024, 32 * g, nullptr, SCALE_D, ws + WS_WDD + a * SZ_WD_D, 32 * g, 64 * kb, scr, lane);
                else cvt_item(ffn_w_down + (size_t)a * DFF * 1024, DFF, 1024, 32 * g, nullptr, (bf16_t*)(ws + WS_WDD + a * SZ_WD_D), 32 * g, 64 * kb, scr, lane); });
            CVT_LOOP(8 * 224 * 16, { const int e = it / (224 * 16), r0 = it % (224 * 16); const int g = r0 / 16, kb = r0 % 16; const int pn = g >> 3, r = g & 7;
                const float* Wsrc = (r < 4 ? moe_w_gate : moe_w_up) + ((size_t)a * 8 + e) * 1024 * DFE;
                if ((a == 0 ? F8_L0 : F8_L1)) cvt_item8(Wsrc, 1024, DFE, 128 * pn + 32 * (r & 3), g_ffn + (2 * a + 1) * 1024, r < 4 ? SCALE_WG8 : SCALE_WU8, ws + (a == 0 ? WS_WGUE0 + e * SZ_WGU_E0 : WS_WGUE1 + e * SZ_WGU_E1), 32 * g, 64 * kb, scr, lane);
                else cvt_item(Wsrc, 1024, DFE, 128 * pn + 32 * (r & 3), g_ffn + (2 * a + 1) * 1024, (bf16_t*)(ws + (a == 0 ? WS_WGUE0 + e * SZ_WGU_E0 : WS_WGUE1 + e * SZ_WGU_E1)), 32 * g, 64 * kb, scr, lane); });
            CVT_LOOP(8 * 32 * 56, { const int e = it / (32 * 56), r0 = it % (32 * 56); const int g = r0 / 56, kb = r0 % 56;
                if ((a == 0 ? F8_L0 : F8_L1)) cvt_item8(moe_w_down + ((size_t)a * 8 + e) * DFE * 1024, DFE, 1024, 32 * g, nullptr, SCALE_D, ws + (a == 0 ? WS_WDE0 + e * SZ_WD_E0 : WS_WDE1 + e * SZ_WD_E1), 32 * g, 64 * kb, scr, lane);
                else cvt_item(moe_w_down + ((size_t)a * 8 + e) * DFE * 1024, DFE, 1024, 32 * g, nullptr, (bf16_t*)(ws + (a == 0 ? WS_WDE0 + e * SZ_WD_E0 : WS_WDE1 + e * SZ_WD_E1)), 32 * g, 64 * kb, scr, lane); });
        }
#undef CVT_LOOP
        for (int i = gw * 64 + lane; i < 2 * 8 * 1024; i += NGW * 64) { const int j = i >> 13, e = (i >> 10) & 7, k = i & 1023;
            ((float*)(ws + WS_WR))[i] = moe_w_router[(size_t)j * 1024 * 8 + k * 8 + e] * g_ffn[(2 * j + 1) * 1024 + k]; }
        for (int m = gw; m < T; m += NGW) {
            const f32x4* xr = (const f32x4*)(x_in + (size_t)m * DM) + lane; f32x4 v[4]; float s = 0.f;
#pragma unroll
            for (int j = 0; j < 4; ++j) { v[j] = xr[64 * j]; s += sq4(v[j]); }
            s = wave_sum(s);
            u32x2* o8 = (u32x2*)(hA + (size_t)m * DM) + lane;
#pragma unroll
            for (int j = 0; j < 4; ++j) { u32x2 w; w.x = cvtpk(v[j][0], v[j][1]); w.y = cvtpk(v[j][2], v[j][3]); o8[64 * j] = w; }
            if (lane < 16) ssh[(size_t)m * 16 + lane] = lane == 0 ? s : 0.f;
        }
        for (int i = gw * 64 + lane; i < T * 32; i += NGW * 64) { const int t = i >> 5, j = i & 31;
            const float inv = powf(10000.0f, -(float)j / 32.0f); const float ang = (float)positions[t] * inv;
            double rev = (double)ang * 0.15915494309189535; rev -= floor(rev); const float rf = (float)rev;
            f32x2 o; o.x = __builtin_amdgcn_cosf(rf); o.y = __builtin_amdgcn_sinf(rf); *(f32x2*)(cs + (size_t)i * 2) = o; }
        GRID_BAR(0);
    }

    for (int l = 0; l < 4; ++l) {
        const int pb = 1 + l * 10;
        if (l < 2) {
            const int a = l;
            if (PHE(1) && IN(pb + 0)) {
                pg8::Sched S; S.init(T / 256, 3, 1024, G, bx, (const bf16_t*)(ws + WS_WIN + a * SZ_WIN));
                EpiLat E{ssh, CQ, CKV, KRb, sslat, cs};
                pg8::gemm_phase<EpiLat, false>(lds, hA, 1024, S, E);
                GRID_BAR(pb + 0);
            }
            if (PHE(2) && IN(pb + 1)) {
                { pg8::Sched S; S.init(T / 256, 6, 384, G, bx, (const bf16_t*)(ws + WS_WUQ + a * SZ_WUQ));
                  EpiQ E{sslat, Qm, cs};
                  pg8::gemm_phase<EpiQ, false>(lds, CQ, 384, S, E); }
                { pg8::Sched S; S.init(T / 256, 8, 256, G, bx, (const bf16_t*)(ws + WS_WUKV + a * SZ_WUKV));
                  EpiScale<4> E{sslat, 8, 1.0f / 256.0f, KVm, 2048};
                  pg8::gemm_phase<EpiScale<4>, false>(lds, CKV, 256, S, E); }
                GRID_BAR(pb + 1);
            }
            if (PHE(3) && IN(pb + 2)) {
                bf16x8 qra[12];
                { int tq = threadIdx.x; asm volatile("" : "+v"(tq)); const int wq = tq >> 6, r32q = tq & 31, hiq = (tq >> 5) & 1, bh0 = vcu >> 2;
                  const char* Qu0 = (const char*)(Qm + ((size_t)(bh0 >> 3) * SEQ + (vcu & 3) * 256 + wq * 32) * 1536 + (bh0 & 7) * 192) + (unsigned)(r32q * 1536 + hiq * 8) * 2u;
#pragma unroll
                  for (int d0 = 0; d0 < 12; ++d0) qra[d0] = *(const bf16x8*)(Qu0 + d0 * 32); }
                for (int id = vcu; id < NB * 8 * 4; id += G) { const int bh = id >> 2, xq = id & 3;
#pragma unroll 1
                    for (int hf = 0; hf < 2; ++hf) { const bool pre = !(id == vcu && hf == 0);
                        int nbh = bh, nqb = 7 - xq;
                        if (hf == 1) { const int nid = id + G; if (nid < NB * 8 * 4) { nbh = nid >> 2; nqb = nid & 3; } else nqb = -1; }
                        mla_attn_block(Qm, KVm, KRb, Om, bh >> 3, bh & 7, hf ? 7 - xq : xq, (LAS char*)lds, qra, pre, nbh >> 3, nbh & 7, nqb); } }
                GRID_BAR(pb + 2);
            }
            if (PHE(4) && IN(pb + 3)) {
                if (F8_WOM) { pg8::Sched S; S.init(T / 256, 4, 1024, G, bx, ws + WS_WOM + a * SZ_WO, 1);
                    EpiResid E{hA, ssh, nullptr, nullptr, 1.0f / (SCALE_GU * SCALE_O)};
                    pg8::gemm_phase<EpiResid, false, true>(lds, Om, 1024, S, E); }
                else { pg8::Sched S; S.init(T / 256, 4, 1024, G, bx, (const bf16_t*)(ws + WS_WOM + a * SZ_WO));
                    EpiResid E{hA, ssh, nullptr, nullptr, 1.0f};
                    pg8::gemm_phase<EpiResid, false>(lds, Om, 1024, S, E); }
                GRID_BAR(pb + 3);
            }
        } else {
            const int b2 = l - 2;
            if (PHE(5) && IN(pb + 0)) {
                pg8::Sched S; S.init(T / 256, b2 == 0 ? 5 : 4, 1024, G, bx, (const bf16_t*)(ws + WS_WQKV + b2 * SZ_WQKV));
                EpiSwaQkv E{ssh, Qs, KVB, swa_b_q + b2 * 1024, kv_b};
                pg8::gemm_phase<EpiSwaQkv, false>(lds, hA, 1024, S, E);
                GRID_BAR(pb + 0);
            }
            if (PHE(6) && IN(pb + 2)) {
                PH_TID;
                LAS int* posl = (LAS int*)(lds + LX_POS); LAS float* biasd = (LAS float*)(lds + LX_BIAS); LAS float* wscr = (LAS float*)(lds + LX_WSC);
                if (tid <= 128) { const int n = tid; int bk;
                    if (n < 16) bk = n; else { bk = 16 + (int)(logf((float)n / 16.0f) / 2.0794415416798357f * 16.0f); bk = bk > 31 ? 31 : bk; }
                    for (int hq = 0; hq < 16; ++hq) biasd[hq * 132 + n] = rel_bias[bk * 16 + hq]; }
                __syncthreads();
                for (int id = vcu; id < NB * 16; id += G)
                    swa_attn_unit(Qs, KVB, Os, positions, swa_sinks + b2 * 16, id >> 4, id & 15, (LAS char*)lds, posl, biasd, wscr);
                GRID_BAR(pb + 2);
            }
            if (PHE(7) && IN(pb + 3)) {
                if (F8_WOS) { pg8::Sched S; S.init(T / 256, 4, 1024, G, bx, ws + WS_WOS + b2 * SZ_WO, 1);
                    EpiResid E{hA, ssh, swa_b_o + b2 * 1024, (F8_D1 && b2 == 0) ? (unsigned char*)hA8 : nullptr, 1.0f / (SCALE_GU * SCALE_O)};
                    pg8::gemm_phase<EpiResid, false, true>(lds, Os, 1024, S, E); }
                else { pg8::Sched S; S.init(T / 256, 4, 1024, G, bx, (const bf16_t*)(ws + WS_WOS + b2 * SZ_WO));
                    EpiResid E{hA, ssh, swa_b_o + b2 * 1024, (F8_D1 && b2 == 0) ? (unsigned char*)hA8 : nullptr, 1.0f};
                    pg8::gemm_phase<EpiResid, false>(lds, Os, 1024, S, E); }
                GRID_BAR(pb + 3);
            }
        }
        const int j = l >> 1;
        const bool f8l = (j == 0) ? (F8_L0 != 0) : (F8_L1 != 0);
        if ((l & 1) == 0) {
            const bool f8d = (F8_D1 != 0) && (j == 1);
            if (PHE(8) && IN(pb + 4)) {
                if (f8d) {
                    pg8::Sched S; S.init(T / 256, 22, 1024, G, bx, ws + WS_WGUD + j * SZ_WGU_D, 1);
                    EpiSwiGlu8D E{ssh, ACT8, DFF};
                    pg8::gemm_phase<EpiSwiGlu8D, false, true>(lds, hA8, 1024, S, E);
                } else {
                    pg8::Sched S; S.init(T / 256, 22, 1024, G, bx, (const bf16_t*)(ws + WS_WGUD + j * SZ_WGU_D));
                    EpiSwiGlu E{ssh, ACT, DFF, nullptr};
                    pg8::gemm_phase<EpiSwiGlu, false>(lds, hA, 1024, S, E);
                }
                GRID_BAR(pb + 4);
            }
            if (PHE(9) && IN(pb + 5)) {
                if (f8d) {
                    pg8::Sched S; S.init(T / 256, 4, DFF, G, bx, ws + WS_WDD + j * SZ_WD_D, 1);
                    EpiResid E{hA, ssh, nullptr, nullptr, 1.0f / SCALE_D};
                    pg8::gemm_phase<EpiResid, false, true>(lds, ACT8, DFF, S, E);
                } else {
                    pg8::Sched S; S.init(T / 256, 4, DFF, G, bx, (const bf16_t*)(ws + WS_WDD + j * SZ_WD_D));
                    EpiResid E{hA, ssh, nullptr, nullptr, 1.0f};
                    pg8::gemm_phase<EpiResid, false>(lds, ACT, DFF, S, E);
                }
                GRID_BAR(pb + 5);
            }
        } else {
            if (PHE(10) && IN(pb + 4)) {
                PH_TID;
                const float* WR = (const float*)(ws + WS_WR) + (size_t)j * 8192;
                float wreg[8][16];
#pragma unroll
                for (int e = 0; e < 8; ++e)
#pragma unroll
                    for (int jj = 0; jj < 2; ++jj) { const f32x4 w0 = *(const f32x4*)(WR + e * 1024 + 512 * jj + 8 * lane), w1 = *(const f32x4*)(WR + e * 1024 + 512 * jj + 8 * lane + 4);
#pragma unroll
                        for (int q = 0; q < 4; ++q) { wreg[e][jj * 8 + q] = w0[q]; wreg[e][jj * 8 + 4 + q] = w1[q]; } }
                LAS int* el = (LAS int*)lds;
                LAS int* wcnt = (LAS int*)(lds + 1024);
                for (int ch = bx; ch < T / 256; ch += G) {
                    const size_t tokw = (size_t)ch * 256 + wave * 32;
                    u32x4 n0 = *(const u32x4*)(hA + tokw * 1024 + 8 * lane), n1 = *(const u32x4*)(hA + tokw * 1024 + 512 + 8 * lane);
                    float nsv = lane < 16 ? ssh[tokw * 16 + lane] : 0.f;
#pragma unroll 1
                    for (int i = 0; i < 32; ++i) { const int tl = wave * 32 + i; const size_t tok = tokw + i;
                        const u32x4 h0 = n0, h1 = n1; const float sv0 = nsv;
                        if (i + 1 < 32) { const size_t tn = tok + 1; n0 = *(const u32x4*)(hA + tn * 1024 + 8 * lane); n1 = *(const u32x4*)(hA + tn * 1024 + 512 + 8 * lane); nsv = lane < 16 ? ssh[tn * 16 + lane] : 0.f; }
                        f32x4 f[4]; unpack8(h0, f[0], f[1]); unpack8(h1, f[2], f[3]);
                        float lg[8];
#pragma unroll
                        for (int e = 0; e < 8; ++e) { float s = 0.f;
#pragma unroll
                            for (int q = 0; q < 16; ++q) s = fmaf(f[q >> 2][q & 3], wreg[e][q], s);
                            lg[e] = wave_sum(s); }
                        float sv = wave_sum(sv0);
                        const float rstd = 1.0f / sqrtf(sv * (1.0f / 1024.0f) + EPS);
                        if (f8l) { const float sa = rstd * SCALE_A8;
                            f32x4 fs[4];
#pragma unroll
                            for (int q = 0; q < 4; ++q) fs[q] = f[q] * sa;
                            u32x2 q0, q1; q0.x = pack4_fp8(fs[0]); q0.y = pack4_fp8(fs[1]); q1.x = pack4_fp8(fs[2]); q1.y = pack4_fp8(fs[3]);
                            *(u32x2*)(hA8 + tok * 1024 + 8 * lane) = q0; *(u32x2*)(hA8 + tok * 1024 + 512 + 8 * lane) = q1; }
                        int e1 = 0; float v1 = lg[0];
#pragma unroll
                        for (int e = 1; e < 8; ++e) if (lg[e] > v1) { v1 = lg[e]; e1 = e; }
                        int e2 = -1; float v2 = -__builtin_inff();
#pragma unroll
                        for (int e = 0; e < 8; ++e) if (e != e1 && lg[e] > v2) { v2 = lg[e]; e2 = e; }
                        const float w1 = 1.0f / (1.0f + __expf((v2 - v1) * rstd)), w2 = 1.0f - w1;
                        if (lane == 0) { el[tl] = e1 | (e2 << 8); tok_e[tok] = e1 | (e2 << 8); *(f32x2*)(tok_w + tok * 2) = (f32x2){w1, w2}; }
                    }
                    __syncthreads();
                    LAS int* pwc = (LAS int*)(lds + 2048);
                    int myp = 0;
                    if (tid < 256) { const int ee = el[tid];
#pragma unroll
                        for (int k = 0; k < 2; ++k) { const int ek = (ee >> (8 * k)) & 255;
#pragma unroll
                            for (int e = 0; e < 8; ++e) { const unsigned long long mk = __ballot(ek == e); if (lane == 0) wcnt[(k * 8 + e) * 4 + wave] = __popcll(mk); } }
                        const int pq = (ee & 255) * 8 + (ee >> 8);
#pragma unroll 8
                        for (int q = 0; q < 64; ++q) { const unsigned long long mk = __ballot(pq == q); if (pq == q) myp = __popcll(mk & ((1ull << lane) - 1ull)); if (lane == 0) pwc[q * 4 + wave] = __popcll(mk); } }
                    __syncthreads();
                    if (tid < 256) { const int ee = el[tid]; const int pq = (ee & 255) * 8 + (ee >> 8); int off = 0;
                        for (int w = 0; w < wave; ++w) off += pwc[pq * 4 + w];
                        tok_rank[((size_t)ch * 256 + tid) * 2] = myp + off; }
                    if (tid < 64) pcnts[ch * 64 + tid] = pwc[tid * 4 + 0] + pwc[tid * 4 + 1] + pwc[tid * 4 + 2] + pwc[tid * 4 + 3];
                    if (tid < 16) cnts[ch * 16 + tid] = wcnt[tid * 4 + 0] + wcnt[tid * 4 + 1] + wcnt[tid * 4 + 2] + wcnt[tid * 4 + 3];
                    __syncthreads();
                }
                GRID_BAR(pb + 4);
            }
            if (PHE(11) && IN(pb + 5)) {
                PH_TID;
                LAS int* cl = (LAS int*)lds;
                LAS int* pc = (LAS int*)(lds + 16384);
                LAS int* tot = (LAS int*)(lds + 81920);
                LAS int* seg = tot + 16;
                LAS int* pre = tot + 32;
                LAS int* dft = tot + 48;
                LAS int* Pt = tot + 64;
                LAS int* mpl = tot + 128;
                LAS int* ppre = tot + 192;
                LAS int* wc2 = tot + 256;
                LAS int* dlt = tot + 320;
                for (int i = tid; i < 4096; i += 512) cl[i] = cnts[i];
                for (int i = tid; i < 16384; i += 512) pc[i] = pcnts[i];
                __syncthreads();
                if (tid < 16) { int run = 0; for (int c = 0; c < 256; ++c) run += cl[c * 16 + tid]; dft[tid] = run; }
                if (tid >= 64 && tid < 128) { const int p_ = tid - 64; int run = 0; for (int c = 0; c < 256; ++c) run += pc[c * 64 + p_]; Pt[p_] = run; mpl[p_] = 0; }
                __syncthreads();
                if (tid == 0) { int bs = 0;
                    for (int e = 0; e < 8; ++e) { const int d_ = dft[8 + e] & 255; dlt[8 + e] = d_; dlt[e] = -d_; bs += d_; }
                    const int up = bs >> 8;
                    for (int u = 0; u < up; ++u) { int be = 0, bv = -1; for (int e = 0; e < 8; ++e) { const int d_ = dlt[8 + e]; if (d_ > bv) { bv = d_; be = e; } } dlt[be] = 256 - dlt[8 + be]; dlt[8 + be] = -1; }
                    int ok = 1;
                    for (int a_ = 0; a_ < 8; ++a_) for (int b_ = 0; b_ < 8; ++b_) { const int da = dlt[a_], db = dlt[b_];
                        if (da > 0 && db < 0) { const int mv = da < -db ? da : -db; if (mv > Pt[a_ * 8 + b_]) ok = 0; mpl[a_ * 8 + b_] = mv; dlt[a_] = da - mv; dlt[b_] = db + mv; } }
                    for (int e = 0; e < 8; ++e) if (dlt[e] != 0) ok = 0;
                    if (!ok) for (int q = 0; q < 64; ++q) mpl[q] = 0; }
                __syncthreads();
                if (tid < 16) { const int k = tid >> 3, e = tid & 7; int mo = 0, mi = 0;
                    for (int o = 0; o < 8; ++o) { mo += mpl[e * 8 + o]; mi += mpl[o * 8 + e]; }
                    tot[tid] = dft[tid] + (k == 0 ? mi - mo : mo - mi); }
                __syncthreads();
                if (tid < 16) { const int k = tid >> 3, e = tid & 7; int s = 0; for (int e2 = 0; e2 < e; ++e2) s += (tot[k * 8 + e2] + 255) & ~255; seg[tid] = s; }
                __syncthreads();
                for (int ch = bx; ch < T / 256; ch += G) {
                    if (tid < 64) { int run = 0; for (int c = 0; c < ch; ++c) run += pc[c * 64 + tid]; ppre[tid] = run; }
                    __syncthreads();
                    if (tid < 16) { const int k = tid >> 3, e = tid & 7; int run = 0; for (int c = 0; c < ch; ++c) run += cl[c * 16 + tid];
                        int mo = 0, mi = 0;
                        for (int o = 0; o < 8; ++o) { const int fo = mpl[e * 8 + o] < ppre[e * 8 + o] ? mpl[e * 8 + o] : ppre[e * 8 + o], fi = mpl[o * 8 + e] < ppre[o * 8 + e] ? mpl[o * 8 + e] : ppre[o * 8 + e]; mo += fo; mi += fi; }
                        pre[tid] = run + (k == 0 ? mi - mo : mo - mi); }
                    int ek0 = 0, ek1 = 0, rk0 = 0, rk1 = 0; float wk0 = 0.f, wk1 = 0.f, rstd = 0.f; size_t tok = 0;
                    if (tid < 256) { tok = (size_t)ch * 256 + tid; const int ee = tok_e[tok]; const int e1 = ee & 255, e2 = ee >> 8, pq = e1 * 8 + e2;
                        const bool flip = ppre[pq] + tok_rank[tok * 2] < mpl[pq];
                        const f32x2 w12 = *(const f32x2*)(tok_w + tok * 2);
                        ek0 = flip ? e2 : e1; ek1 = flip ? e1 : e2; wk0 = flip ? w12.y : w12.x; wk1 = flip ? w12.x : w12.y;
                        const f32x4* sp = (const f32x4*)(ssh + tok * 16); const f32x4 s0 = sp[0], s1 = sp[1], s2 = sp[2], s3 = sp[3];
                        const float ssum = ((s0[0] + s0[1]) + (s0[2] + s0[3])) + ((s1[0] + s1[1]) + (s1[2] + s1[3])) + ((s2[0] + s2[1]) + (s2[2] + s2[3])) + ((s3[0] + s3[1]) + (s3[2] + s3[3]));
                        rstd = 1.0f / sqrtf(ssum * (1.0f / 1024.0f) + EPS);
#pragma unroll
                        for (int e = 0; e < 8; ++e) { const unsigned long long mk = __ballot(ek0 == e); if (ek0 == e) rk0 = __popcll(mk & ((1ull << lane) - 1ull)); if (lane == 0) wc2[e * 4 + wave] = __popcll(mk); }
#pragma unroll
                        for (int e = 0; e < 8; ++e) { const unsigned long long mk = __ballot(ek1 == e); if (ek1 == e) rk1 = __popcll(mk & ((1ull << lane) - 1ull)); if (lane == 0) wc2[(8 + e) * 4 + wave] = __popcll(mk); } }
                    __syncthreads();
                    if (tid < 256) { int off0 = 0, off1 = 0;
                        for (int w = 0; w < wave; ++w) { off0 += wc2[ek0 * 4 + w]; off1 += wc2[(8 + ek1) * 4 + w]; }
                        const int pos0 = seg[ek0] + pre[ek0] + rk0 + off0, pos1 = seg[8 + ek1] + pre[8 + ek1] + rk1 + off1;
                        idxs[pos0] = (int)tok; wls[pos0] = wk0; rsls[pos0] = rstd;
                        idxs[(size_t)MOE_ROWS + pos1] = (int)tok; wls[(size_t)MOE_ROWS + pos1] = wk1; rsls[(size_t)MOE_ROWS + pos1] = rstd; }
                    __syncthreads();
                }
                for (int jj = bx; jj < 16; jj += G) { const int k = jj >> 3; const int total = tot[jj], padded = (total + 255) & ~255;
                    for (int r = total + tid; r < padded; r += 512) { idxs[(size_t)k * MOE_ROWS + seg[jj] + r] = -1; wls[(size_t)k * MOE_ROWS + seg[jj] + r] = 0.f; rsls[(size_t)k * MOE_ROWS + seg[jj] + r] = 0.f; } }
                if (bx == 0 && tid < 16) { const int k = tid >> 3, e = tid & 7; const int t0 = seg[tid] >> 8, t1 = (seg[tid] + ((tot[tid] + 255) & ~255)) >> 8;
                    for (int tI = t0; tI < t1; ++tI) texp_g[k * 512 + tI] = e;
                    if (e == 7) texp_g[k * 512 + 300] = t1; }
                GRID_BAR(pb + 5);
            }
            for (int k = 0; k < 2; ++k) {
                const int* idxk = idxs + (size_t)k * MOE_ROWS; const float* wlk = wls + (size_t)k * MOE_ROWS; const int* texpk = texp_g + k * 512;
                if (PHE(12) && IN(pb + 6 + 2 * k)) {
                    const int ntl = __builtin_amdgcn_readfirstlane(texpk[300]);
                    if (f8l) {
                        pg8::Sched S; S.init(ntl, 28, 1024, G, bx, ws + (j == 0 ? WS_WGUE0 : WS_WGUE1), 1); S.texp = texpk; S.estride = (j == 0 ? SZ_WGU_E0 : SZ_WGU_E1); S.idx = idxk;
                        if (k == 1) S.skip(__builtin_amdgcn_readfirstlane((4 * texp_g[300]) % G));
                        EpiSwiGlu8 E{rsls + (size_t)k * MOE_ROWS, ACT8 + (size_t)k * AR_ACTB, DFE};
                        pg8::gemm_phase<EpiSwiGlu8, true, true>(lds, hA8, 1024, S, E);
                    } else {
                        pg8::Sched S; S.init(ntl, 28, 1024, G, bx, ws + (j == 0 ? WS_WGUE0 : WS_WGUE1)); S.texp = texpk; S.estride = (j == 0 ? SZ_WGU_E0 : SZ_WGU_E1); S.idx = idxk;
                        EpiSwiGlu E{ssh, ACT, DFE, idxk};
                        pg8::gemm_phase<EpiSwiGlu, true>(lds, hA, 1024, S, E);
                    }
                    GRID_BAR(pb + 6 + 2 * k);
                }
                if (PHE(13) && IN(pb + 7 + 2 * k)) {
                    const int ntl = __builtin_amdgcn_readfirstlane(texpk[300]);
                    if (f8l) {
                        pg8::Sched S; S.init(ntl, 4, DFE, G, bx, ws + (j == 0 ? WS_WDE0 : WS_WDE1), 1); S.texp = texpk; S.estride = (j == 0 ? SZ_WD_E0 : SZ_WD_E1);
                        EpiMoeDown E{k == 0 ? hA : hB, k == 0 ? hB : hA, ssh, idxk, wlk, k, 1.0f / SCALE_D};
                        pg8::gemm_phase<EpiMoeDown, false, true>(lds, ACT8 + (size_t)k * AR_ACTB, DFE, S, E);
                    } else {
                        pg8::Sched S; S.init(ntl, 4, DFE, G, bx, ws + (j == 0 ? WS_WDE0 : WS_WDE1)); S.texp = texpk; S.estride = (j == 0 ? SZ_WD_E0 : SZ_WD_E1);
                        EpiMoeDown E{k == 0 ? hA : hB, k == 0 ? hB : hA, ssh, idxk, wlk, k, 1.0f};
                        pg8::gemm_phase<EpiMoeDown, false>(lds, ACT, DFE, S, E);
                    }
                    if (!(f8l && k == 0)) GRID_BAR(pb + 7 + 2 * k);
                }
            }
        }
    }
    if (PHE(14) && IN(41)) {
        PH_TID;
        for (int m = gw; m < T; m += NGW) {
            float sv = lane < 16 ? ssh[(size_t)m * 16 + lane] : 0.f; sv = wave_sum(sv);
            const float rstd = 1.0f / sqrtf(sv * (1.0f / 1024.0f) + EPS);
            const u32x2* hr = (const u32x2*)(hA + (size_t)m * DM) + lane; f32x4* orow = (f32x4*)(args.out + (size_t)m * DM) + lane; const f32x4* gr = (const f32x4*)g_final + lane;
#pragma unroll
            for (int jx = 0; jx < 4; ++jx) { const u32x2 w = hr[64 * jx]; const f32x4 g = gr[64 * jx]; f32x4 o;
                o[0] = __uint_as_float(w.x << 16) * rstd * g[0]; o[1] = __uint_as_float(w.x & 0xffff0000u) * rstd * g[1];
                o[2] = __uint_as_float(w.y << 16) * rstd * g[2]; o[3] = __uint_as_float(w.y & 0xffff0000u) * rstd * g[3]; orow[64 * jx] = o; }
        }
    }
#undef IN
#undef GRID_BAR
}

extern "C" void kernel_launch(void* const* d_in, const int* in_sizes, int n_in, void* d_out, int out_size, void* d_ws, size_t ws_size, hipStream_t stream) {
    static int grid = 0;
    if (grid == 0) {
        if (n_in != 27 || out_size != T * DM || ws_size < WS_END) { fprintf(stderr, "kernel_launch: unexpected shapes (n_in %d, out %d, ws %zu, need %zu)\n", n_in, out_size, ws_size, (size_t)WS_END); grid = -1; return; }
        int dev = 0, cus = 0;
        if (hipGetDevice(&dev) != hipSuccess || hipDeviceGetAttribute(&cus, hipDeviceAttributeMultiprocessorCount, dev) != hipSuccess) { grid = -1; return; }
        if (hipFuncSetAttribute((const void*)yoco_fwd, hipFuncAttributeMaxDynamicSharedMemorySize, LDS_BYTES) != hipSuccess) { fprintf(stderr, "kernel_launch: hipFuncSetAttribute failed\n"); grid = -1; return; }
        int per_cu = 0;
        if (hipOccupancyMaxActiveBlocksPerMultiprocessor(&per_cu, (const void*)yoco_fwd, 512, LDS_BYTES) != hipSuccess || per_cu < 1) { fprintf(stderr, "kernel_launch: occupancy query reports %d\n", per_cu); }
        (void)hipGetLastError();
        grid = cus - cus % 8;
    }
    if (grid < 0) return;
    (void)hipMemsetAsync((char*)d_ws + WS_CTL, 0, CTL_BYTES, stream);
    Args a{};
    for (int i = 0; i < 27; ++i) a.in[i] = d_in[i];
    a.out = (float*)d_out; a.ws = (unsigned char*)d_ws;
#if MK_PER_PHASE
    for (int p = 0; p <= 41; ++p) { a.ph_lo = p; a.ph_hi = p + 1; hipLaunchKernelGGL(yoco_fwd, dim3(grid), dim3(512), LDS_BYTES, stream, a); }
#else
    a.ph_lo = 0; a.ph_hi = 1000;
    hipLaunchKernelGGL(yoco_fwd, dim3(grid), dim3(512), LDS_BYTES, stream, a);
#endif
}
```

```cpp
#include <hip/hip_runtime.h>
#include <cstdio>
#include <cstdint>

#ifndef MK_PER_PHASE
#define MK_PER_PHASE 0
#endif

#ifndef F8_L0
#define F8_L0 1
#endif
#ifndef F8_L1
#define F8_L1 1
#endif
#ifndef F8_WOM
#define F8_WOM 1
#endif
#ifndef F8_WOS
#define F8_WOS 1
#endif
#ifndef F8_D1
#define F8_D1 1
#endif
#define GAS __attribute__((address_space(1)))
#define LAS __attribute__((address_space(3)))
typedef unsigned short bf16_t;
typedef short bf16x8 __attribute__((ext_vector_type(8)));
typedef short s16x4 __attribute__((ext_vector_type(4)));
typedef float f32x2 __attribute__((ext_vector_type(2)));
typedef float f32x4 __attribute__((ext_vector_type(4)));
typedef float f32x16 __attribute__((ext_vector_type(16)));
typedef unsigned u32x2 __attribute__((ext_vector_type(2)));
typedef unsigned u32x4 __attribute__((ext_vector_type(4)));
typedef int i32x4 __attribute__((ext_vector_type(4)));
typedef int i32x8 __attribute__((ext_vector_type(8)));

constexpr int T = 65536, DM = 1024, SEQ = 2048, NB = 32;
constexpr int QLORA = 384, KVLORA = 256, ROPE = 64, LATN = 704;
constexpr int DFF = 2816, DFE = 3584, NEXP = 8;
constexpr float EPS = 1e-6f;
constexpr int MOE_ROWS = T + NEXP * 256;

constexpr size_t MiB = 1u << 20;
constexpr size_t SZ_WIN = 768ull * 1024 * 2, SZ_WUQ = 1536ull * 384 * 2, SZ_WUKV = 2048ull * 256 * 2, SZ_WO = 1024ull * 1024 * 2;
constexpr size_t SZ_WQKV = 1280ull * 1024 * 2;
constexpr size_t SZ_WGU_D = 5632ull * 1024 * 2, SZ_WD_D = 1024ull * 2816 * 2;
constexpr size_t SZ_WGU_E0 = 7168ull * 1024 * (F8_L0 ? 1 : 2), SZ_WD_E0 = 1024ull * 3584 * (F8_L0 ? 1 : 2);
constexpr size_t SZ_WGU_E1 = 7168ull * 1024 * (F8_L1 ? 1 : 2), SZ_WD_E1 = 1024ull * 3584 * (F8_L1 ? 1 : 2);
constexpr float SCALE_O = 32.0f;
constexpr float SCALE_A8 = 0.125f, SCALE_WG8 = -1.4426950408889634f / SCALE_A8, SCALE_WU8 = -0.6931471805599453f / SCALE_A8;
constexpr float SCALE_GU = 32.0f, SCALE_D = 64.0f;
constexpr size_t SZ_WR = 8ull * 1024 * 4;
constexpr size_t WS_CTL = 0, CTL_BYTES = 1 * MiB;
constexpr size_t WS_WIN = 1 * MiB;
constexpr size_t WS_WUQ = WS_WIN + 2 * SZ_WIN;
constexpr size_t WS_WUKV = WS_WUQ + 2 * SZ_WUQ;
constexpr size_t WS_WOM = WS_WUKV + 2 * SZ_WUKV;
constexpr size_t WS_WQKV = WS_WOM + 2 * SZ_WO;
constexpr size_t WS_WOS = WS_WQKV + 2 * SZ_WQKV;
constexpr size_t WS_WGUD = WS_WOS + 2 * SZ_WO;
constexpr size_t WS_WDD = WS_WGUD + 2 * SZ_WGU_D;
constexpr size_t WS_WGUE0 = WS_WDD + 2 * SZ_WD_D;
constexpr size_t WS_WGUE1 = WS_WGUE0 + 8 * SZ_WGU_E0;
constexpr size_t WS_WDE0 = WS_WGUE1 + 8 * SZ_WGU_E1;
constexpr size_t WS_WDE1 = WS_WDE0 + 8 * SZ_WD_E0;
constexpr size_t WS_WR = WS_WDE1 + 8 * SZ_WD_E1;
constexpr size_t WS_WEND = WS_WR + 2 * SZ_WR;
constexpr size_t WS_H = (WS_WEND + MiB - 1) / MiB * MiB;
constexpr size_t WS_SS = WS_H + (size_t)T * DM * 2;
constexpr size_t WS_KVB = WS_SS + (size_t)T * 16 * 4;
constexpr size_t WS_ROUTE = WS_KVB + (size_t)T * 256 * 2;
constexpr size_t RT_TOKE = 0, RT_TOKW = RT_TOKE + (size_t)T * 4, RT_RANK = RT_TOKW + (size_t)T * 8, RT_CNT = RT_RANK + (size_t)T * 8,
                 RT_IDX = RT_CNT + 256 * 16 * 4, RT_WL = RT_IDX + 2ull * MOE_ROWS * 4, RT_TEXP = RT_WL + 2ull * MOE_ROWS * 4, RT_RSL = RT_TEXP + 2 * 512 * 4, RT_PCNT = RT_RSL + 2ull * MOE_ROWS * 4, RT_END = RT_PCNT + 256 * 64 * 4;
static_assert(RT_END <= 3 * MiB, "route tables");
constexpr size_t WS_ARENA = WS_ROUTE + 3 * MiB;
constexpr size_t AR_CQ = 0, AR_CKV = AR_CQ + (size_t)T * 384 * 2, AR_KR = AR_CKV + (size_t)T * 256 * 2, AR_Q = AR_KR + (size_t)T * 64 * 2,
                 AR_O = AR_Q + (size_t)T * 1536 * 2, AR_MLA_END = AR_O + (size_t)T * 1024 * 2;
constexpr size_t AR_CS = AR_MLA_END, AR_SSLAT = AR_CS + (size_t)T * 64 * 4, AR_X_END = AR_SSLAT + (size_t)T * 16 * 4;
constexpr size_t AR_H8 = 256 * MiB;
constexpr size_t AR_ACT = 0;
constexpr size_t AR_SQ = 0, AR_SO = (size_t)T * 1024 * 2;
constexpr size_t AR_ACTB = 320 * MiB;
constexpr size_t ARENA_BYTES = AR_ACTB + (size_t)MOE_ROWS * DFE;
static_assert(AR_X_END <= ARENA_BYTES && (size_t)T * DFF * 2 <= AR_CS && (size_t)MOE_ROWS * DFE * 2 <= ARENA_BYTES && AR_H8 + (size_t)T * DM <= AR_ACTB, "arena overlays");
constexpr size_t WS_END = WS_ARENA + ARENA_BYTES;

constexpr int CW_BAR = 4096;

constexpr int RING_BYTES = 131072;
constexpr int LDSCTL_OFF = RING_BYTES, MISC_OFF = LDSCTL_OFF + 320;
constexpr int LX_POS = RING_BYTES + 512;
constexpr int LX_BIAS = LX_POS + 1536;
constexpr int LX_WSC = LX_BIAS + 8448;
constexpr int LDS_BYTES = 147456;
static_assert(LX_WSC + 2048 <= LDS_BYTES, "LDS map");

__device__ __forceinline__ unsigned cvtpk(float lo, float hi) { unsigned r; asm volatile("v_cvt_pk_bf16_f32 %0, %1, %2" : "=v"(r) : "v"(lo), "v"(hi)); return r; }
__device__ __forceinline__ u32x4 pack8u(f32x4 a, f32x4 b) { u32x4 w; w.x = cvtpk(a[0], a[1]); w.y = cvtpk(a[2], a[3]); w.z = cvtpk(b[0], b[1]); w.w = cvtpk(b[2], b[3]); return w; }
__device__ __forceinline__ void store8(bf16_t* p, f32x4 a, f32x4 b) { *(u32x4*)p = pack8u(a, b); }
__device__ __forceinline__ void unpack8(u32x4 w, f32x4& a, f32x4& b) {
    a[0] = __uint_as_float(w.x << 16); a[1] = __uint_as_float(w.x & 0xffff0000u); a[2] = __uint_as_float(w.y << 16); a[3] = __uint_as_float(w.y & 0xffff0000u);
    b[0] = __uint_as_float(w.z << 16); b[1] = __uint_as_float(w.z & 0xffff0000u); b[2] = __uint_as_float(w.w << 16); b[3] = __uint_as_float(w.w & 0xffff0000u);
}
__device__ __forceinline__ unsigned pack4_fp8(f32x4 v) { int w = 0; w = __builtin_amdgcn_cvt_pk_fp8_f32(v[0], v[1], w, false); w = __builtin_amdgcn_cvt_pk_fp8_f32(v[2], v[3], w, true); return (unsigned)w; }
__device__ __forceinline__ float sq4(f32x4 v) { return (v[0] * v[0] + v[1] * v[1]) + (v[2] * v[2] + v[3] * v[3]); }
__device__ __forceinline__ float qx1(float v) { return __int_as_float(__builtin_amdgcn_update_dpp(0, __float_as_int(v), 0xB1, 0xF, 0xF, true)); }
__device__ __forceinline__ float qx2(float v) { return __int_as_float(__builtin_amdgcn_update_dpp(0, __float_as_int(v), 0x4E, 0xF, 0xF, true)); }
__device__ __forceinline__ float qx3(float v) { return __int_as_float(__builtin_amdgcn_update_dpp(0, __float_as_int(v), 0x1B, 0xF, 0xF, true)); }
__device__ __forceinline__ float red_fq(float s) { s += __shfl_xor(s, 16); s += __shfl_xor(s, 32); return s; }
__device__ __forceinline__ float wave_sum(float v) {
#pragma unroll
    for (int o = 1; o < 64; o <<= 1) v += __shfl_xor(v, o);
    return v;
}
template <int NS> __device__ __forceinline__ float row_rstd(const float* ss, size_t row, int slot_lo, float inv_dim, int fq) {
    float s = 0.f;
    if (NS == 16 || 4 * fq < NS) { const f32x4 v = *(const f32x4*)(ss + row * 16 + slot_lo + 4 * fq); s = (v[0] + v[1]) + (v[2] + v[3]); }
    s = red_fq(s);
    return 1.0f / sqrtf(s * inv_dim + EPS);
}
__device__ __forceinline__ f32x4 silu_mul_rs(f32x4 g, f32x4 u, float c1, float c2) {
    f32x4 r;
#pragma unroll
    for (int e = 0; e < 4; ++e) { const float s = __builtin_amdgcn_rcpf(1.0f + __builtin_amdgcn_exp2f(c1 * g[e])); float t = c2 * s; t = u[e] * t; r[e] = g[e] * t; }
    return r;
}
__device__ __forceinline__ void rope4(f32x4 x1, f32x4 x2, f32x4 ta, f32x4 tb, f32x4& o1, f32x4& o2) {
    o1[0] = x1[0] * ta[0] - x2[0] * ta[1]; o2[0] = x2[0] * ta[0] + x1[0] * ta[1];
    o1[1] = x1[1] * ta[2] - x2[1] * ta[3]; o2[1] = x2[1] * ta[2] + x1[1] * ta[3];
    o1[2] = x1[2] * tb[0] - x2[2] * tb[1]; o2[2] = x2[2] * tb[0] + x1[2] * tb[1];
    o1[3] = x1[3] * tb[2] - x2[3] * tb[3]; o2[3] = x2[3] * tb[2] + x1[3] * tb[3];
}

namespace pg8 {
constexpr int BM = 256, BK = 64, HALF = 128, HTB = HALF * BK * 2, STAGE_BYTES = 8 * HTB, NXCD = 8, WGM = 8;
__host__ __device__ __forceinline__ int lds_byte(int r, int c) { const int st = (r >> 4) * 2 + (c >> 5), rr = r & 15, cc = c & 31, ob = rr * 64 + cc * 2; return st * 1024 + (ob ^ (((ob >> 9) & 1) << 5)); }
__host__ __device__ __forceinline__ void stage_rc(int b, int& R, int& C) { const int st = b / 1024, sb = b % 1024, swz = sb ^ (((sb >> 9) & 1) << 5); R = (st >> 1) * 16 + swz / 64; C = (st & 1) * 32 + (swz % 64) / 2; }
__host__ __device__ __forceinline__ int perm32(int rho) { const int n = rho >> 4, i = rho & 15; return 8 * (i >> 2) + 4 * n + (i & 3); }
struct Unit { int pm, pn; };
__device__ __forceinline__ void glds16_x2(const void* sbase, unsigned voff0, unsigned voff1, unsigned ldsaddr) {
    asm volatile("s_mov_b32 m0, %3\n\ts_nop 0\n\tglobal_load_lds_dwordx4 %0, %2\n\ts_mov_b32 m0, %4\n\ts_nop 0\n\tglobal_load_lds_dwordx4 %1, %2" :: "v"(voff0), "v"(voff1), "s"(sbase), "s"(ldsaddr), "s"(ldsaddr + 8192u) : "memory"); }

struct Sched {
    int nM, nN; const char* Bt; size_t tstepB; const int* texp; size_t estride; const int* idx;
    int per, kq, start, len, skipme, pe, ke, base;
    static constexpr int ESKIP = 3;
    __device__ __forceinline__ void init(int nM_, int nN_, int K, int G_, int c_, const void* Bt_, int esz = 2) { nM = nM_; nN = nN_; Bt = (const char*)Bt_; tstepB = (size_t)BM * K * esz; texp = nullptr; estride = 0; idx = nullptr;
        const int nwg = nM * nN, x = c_ % NXCD, q = nwg / NXCD, r = nwg % NXCD; per = G_ / NXCD; kq = c_ / NXCD; len = q + (x < r ? 1 : 0); start = x * q + (x < r ? x : r);
        skipme = 0; pe = per; ke = kq; base = kq; xq = x; }
    int xq;
    __device__ __forceinline__ void skip(int rE) { const int ex = rE > xq ? (rE - xq + NXCD - 1) / NXCD : 0; skipme = kq < ex ? ESKIP : 0; pe = per - ex; ke = kq - ex; base = kq - ESKIP * ex; }
    __device__ __forceinline__ bool next(int i, Unit& u) const {
        const int ii = i + skipme, jv = ii < ESKIP ? ii * pe + ke : base + ii * per;
        if (jv >= len) return false;
        const int wgid = start + jv;
        const int nig = WGM * nN, gid = wgid / nig, fm = gid * WGM, gsz = (nM - fm) < WGM ? (nM - fm) : WGM;
        u.pm = fm + ((wgid % nig) % gsz); u.pn = (wgid % nig) / gsz; return true;
    }
    __device__ __forceinline__ const char* bptr(const Unit& u) const { const size_t e = texp ? (size_t)texp[u.pm] * estride : 0; return Bt + e + (size_t)u.pn * tstepB; }
    __device__ __forceinline__ void arows(const Unit& u, int tid_, int rowB, unsigned (&off)[2][2]) const {
        asm volatile("" : "+v"(tid_));
#pragma unroll
        for (int i = 0; i < 2; ++i) { int R, C; stage_rc(tid_ * 16 + i * 8192, R, C);
#pragma unroll
            for (int h = 0; h < 2; ++h) { int tok = idx[u.pm * BM + h * HALF + R]; tok = tok < 0 ? 0 : tok; off[h][i] = (unsigned)tok * (unsigned)rowB + (unsigned)(C * 2); } }
    }
};

template <class Epi, bool GATHER, bool F8 = false>
__device__ __forceinline__ void gemm_phase(LAS unsigned char* lds, const void* Abase, const int K, const Sched& S, const Epi& E) {
    int tid = threadIdx.x; asm volatile("" : "+v"(tid));
    const int wid = __builtin_amdgcn_readfirstlane(tid >> 6), lane = tid & 63, wr = wid >> 2, wc = wid & 3, fr = lane & 15, fq = lane >> 4;
    const int rowB = F8 ? K : 2 * K;
    const int nt = rowB / 128;
    int Rr[2], Cc[2]; unsigned voffB[2];
#pragma unroll
    for (int i = 0; i < 2; ++i) { int R, C; stage_rc(tid * 16 + i * 8192, R, C); Rr[i] = R; Cc[i] = C; const int Rb = (R & ~31) + perm32(R & 31); voffB[i] = (unsigned)(Rb * rowB + C * 2); }
    const size_t kstep = (size_t)(BK * 2);
    const size_t hstep = (size_t)HALF * rowB;
    const size_t tstep = 2 * hstep;
    const unsigned ldsw = (unsigned)wid * 1024u;
    const unsigned ldsbase = (unsigned)(uintptr_t)lds;
    const int aoff = lds_byte(wr * 64 + fr, fq * 8), boff = lds_byte(wc * 32 + fr, fq * 8);
#define PG8_SA(b, h) (((b) * 2 + (h)) * HTB)
#define PG8_SB(b, h) ((4 + (b) * 2 + (h)) * HTB)
#define PG8_STAGE(bufoff, gbase, voff) glds16_x2((const void*)(gbase), (voff)[0], (voff)[1], ldsbase + (unsigned)(bufoff) + ldsw)
#define PG8_LDA(dst, b, h) do { _Pragma("unroll") for (int m = 0; m < 4; ++m) _Pragma("unroll") for (int k = 0; k < 2; ++k) dst[m][k] = *(const LAS bf16x8*)(lds + PG8_SA(b, h) + aoff + m * 2048 + k * 1024); } while (0)
#define PG8_LDB(dst, b, h) do { _Pragma("unroll") for (int n = 0; n < 2; ++n) _Pragma("unroll") for (int k = 0; k < 2; ++k) dst[n][k] = *(const LAS bf16x8*)(lds + PG8_SB(b, h) + boff + n * 2048 + k * 1024); } while (0)
#define PG8_F8OP(X) __builtin_shufflevector(__builtin_bit_cast(i32x4, X[0]), __builtin_bit_cast(i32x4, X[1]), 0, 1, 2, 3, 4, 5, 6, 7)
#define PG8_MMA(ai, bj, At, Bt) do { __builtin_amdgcn_s_setprio(1); _Pragma("unroll") for (int m = 0; m < 4; ++m) _Pragma("unroll") for (int n = 0; n < 2; ++n) { \
        if constexpr (F8) { f32x16& B_ = big[(ai) * 4 + (bj) * 2 + (m >> 1)]; constexpr int o_ = 0; const int q_ = ((m & 1) * 2 + n) * 4; (void)o_; \
            f32x4 s_ = {B_[q_], B_[q_ + 1], B_[q_ + 2], B_[q_ + 3]}; \
            s_ = __builtin_amdgcn_mfma_scale_f32_16x16x128_f8f6f4(PG8_F8OP(Bt[n]), PG8_F8OP(At[m]), s_, 0, 0, 0, 0, 0, 0); \
            B_[q_] = s_[0]; B_[q_ + 1] = s_[1]; B_[q_ + 2] = s_[2]; B_[q_ + 3] = s_[3]; } \
        else { _Pragma("unroll") for (int k = 0; k < 2; ++k) acc[ai][bj][m][n] = __builtin_amdgcn_mfma_f32_16x16x32_bf16(Bt[n][k], At[m][k], acc[ai][bj][m][n], 0, 0, 0); } } __builtin_amdgcn_s_setprio(0); } while (0)
#define PG8_WAIT_V(n) asm volatile("s_waitcnt vmcnt(" #n ")" ::: "memory")
#define PG8_WAIT_L(n) asm volatile("s_waitcnt lgkmcnt(" #n ")" ::: "memory")
#define PG8_BAR __builtin_amdgcn_s_barrier()
#define PG8_SCHED __builtin_amdgcn_sched_barrier(0)
    Unit cur, nxt; int ui = 0;
    if (!S.next(0, cur)) return;
    f32x4 acc[2][2][4][2];
#pragma unroll
    for (int a = 0; a < 2; ++a)
#pragma unroll
        for (int b = 0; b < 2; ++b)
#pragma unroll
            for (int m = 0; m < 4; ++m)
#pragma unroll
                for (int n = 0; n < 2; ++n) acc[a][b][m][n] = (f32x4){0.f, 0.f, 0.f, 0.f};
    bf16x8 At[4][2], B0[2][2], B1[2][2];
    f32x16 big[8];
    if constexpr (F8) {
#pragma unroll
        for (int i = 0; i < 8; ++i) big[i] = f32x16{}; }
    unsigned cvo[2][2], nvo[2][2];
    const char* cA; const char* cB = S.bptr(cur);
    if constexpr (GATHER) { cA = (const char*)Abase; S.arows(cur, tid, rowB, cvo); }
    else { cA = (const char*)Abase + (size_t)cur.pm * tstep;
#pragma unroll
        for (int h = 0; h < 2; ++h)
#pragma unroll
            for (int i = 0; i < 2; ++i) cvo[h][i] = (unsigned)((h * HALF + Rr[i]) * rowB + Cc[i] * 2); }
    PG8_STAGE(PG8_SB(0, 0), cB, voffB); PG8_STAGE(PG8_SB(0, 1), cB + hstep, voffB); PG8_STAGE(PG8_SA(0, 0), cA, cvo[0]); PG8_STAGE(PG8_SA(0, 1), cA, cvo[1]);
    if (wr == 1) PG8_BAR;
    PG8_WAIT_V(2); PG8_BAR;
    PG8_STAGE(PG8_SB(1, 0), cB + kstep, voffB); PG8_STAGE(PG8_SA(1, 0), cA + kstep, cvo[0]); PG8_STAGE(PG8_SB(1, 1), cB + hstep + kstep, voffB);
    PG8_WAIT_V(6); PG8_BAR;
    for (;;) {
        const bool has_next = S.next(ui + 1, nxt);
        const char* nA; const char* nB;
        if (has_next) { nB = S.bptr(nxt);
            if constexpr (GATHER) { nA = (const char*)Abase;
                if (nxt.pm != cur.pm) S.arows(nxt, tid, rowB, nvo);
                else {
#pragma unroll
                    for (int h = 0; h < 2; ++h)
#pragma unroll
                        for (int i = 0; i < 2; ++i) nvo[h][i] = cvo[h][i]; } }
            else { nA = (const char*)Abase + (size_t)nxt.pm * tstep; } }
        else { nA = cA; nB = cB;
            if constexpr (GATHER) {
#pragma unroll
                for (int h = 0; h < 2; ++h)
#pragma unroll
                    for (int i = 0; i < 2; ++i) nvo[h][i] = cvo[h][i]; } }
#pragma unroll 1
        for (int t = 0; t < nt; t += 2) {
            const bool last = (t == nt - 2);
            const char* a1 = cA + (size_t)(t + 1) * kstep;
            const char* a2 = last ? nA : cA + (size_t)(t + 2) * kstep; const char* b2 = last ? nB : cB + (size_t)(t + 2) * kstep;
            const char* a3 = a2 + kstep; const char* b3 = b2 + kstep;
            unsigned v2[2][2];
#pragma unroll
            for (int h = 0; h < 2; ++h)
#pragma unroll
                for (int i = 0; i < 2; ++i) { if constexpr (GATHER) v2[h][i] = last ? nvo[h][i] : cvo[h][i]; else v2[h][i] = cvo[h][i]; }
            PG8_LDB(B0, 0, 0); PG8_LDB(B1, 0, 1); PG8_SCHED; PG8_LDA(At, 0, 0); PG8_STAGE(PG8_SA(1, 1), a1, cvo[1]);
            PG8_WAIT_V(8); PG8_WAIT_L(0); PG8_BAR; PG8_MMA(0, 0, At, B0); PG8_MMA(0, 1, At, B1); PG8_BAR; PG8_SCHED;
            PG8_LDA(At, 0, 1); PG8_STAGE(PG8_SB(0, 0), b2, voffB); PG8_STAGE(PG8_SB(0, 1), b2 + hstep, voffB); PG8_STAGE(PG8_SA(0, 0), a2, v2[0]);
            PG8_WAIT_V(8); PG8_WAIT_L(0); PG8_BAR; PG8_MMA(1, 0, At, B0); PG8_MMA(1, 1, At, B1); PG8_BAR; PG8_SCHED;
            PG8_LDB(B0, 1, 0); PG8_LDB(B1, 1, 1); PG8_SCHED; PG8_LDA(At, 1, 0); PG8_STAGE(PG8_SA(0, 1), a2, v2[1]);
            PG8_WAIT_V(8); PG8_WAIT_L(0); PG8_BAR; PG8_MMA(0, 0, At, B0); PG8_MMA(0, 1, At, B1); PG8_BAR; PG8_SCHED;
            PG8_LDA(At, 1, 1); PG8_STAGE(PG8_SB(1, 0), b3, voffB); PG8_STAGE(PG8_SB(1, 1), b3 + hstep, voffB); PG8_STAGE(PG8_SA(1, 0), a3, v2[0]);
            PG8_WAIT_V(8); PG8_WAIT_L(0); PG8_BAR; PG8_MMA(1, 0, At, B0); PG8_MMA(1, 1, At, B1); PG8_BAR; PG8_SCHED;
        }
        if (wr == 0) PG8_BAR;
        if constexpr (F8) {
#pragma unroll
            for (int a = 0; a < 2; ++a)
#pragma unroll
                for (int b = 0; b < 2; ++b)
#pragma unroll
                    for (int m = 0; m < 4; ++m)
#pragma unroll
                        for (int n = 0; n < 2; ++n) { const f32x16& B_ = big[a * 4 + b * 2 + (m >> 1)]; const int q_ = ((m & 1) * 2 + n) * 4; acc[a][b][m][n] = (f32x4){B_[q_], B_[q_ + 1], B_[q_ + 2], B_[q_ + 3]}; }
        }
        { int fr_ = fr, fq_ = fq; asm volatile("" : "+v"(fr_), "+v"(fq_));
          E(acc, cur, wr, wc, fr_, fq_); }
        if constexpr (F8) {
            u32x4 zz; asm volatile("v_mov_b32 %0, 0\n\tv_mov_b32 %1, 0\n\tv_mov_b32 %2, 0\n\tv_mov_b32 %3, 0" : "=v"(zz.x), "=v"(zz.y), "=v"(zz.z), "=v"(zz.w)); const bf16x8 z8 = __builtin_bit_cast(bf16x8, zz);
#pragma unroll
            for (int i = 0; i < 8; ++i) { asm volatile("" : "+v"(zz)); const bf16x8 zi = __builtin_bit_cast(bf16x8, zz); big[i] = __builtin_amdgcn_mfma_f32_32x32x16_bf16(zi, zi, f32x16{}, 0, 0, 0); } }
        if (!has_next) break;
#pragma unroll
        for (int a = 0; a < 2; ++a)
#pragma unroll
            for (int b = 0; b < 2; ++b)
#pragma unroll
                for (int m = 0; m < 4; ++m)
#pragma unroll
                    for (int n = 0; n < 2; ++n) acc[a][b][m][n] = (f32x4){0.f, 0.f, 0.f, 0.f};
        cur = nxt; cA = nA; cB = nB; ++ui;
        if constexpr (GATHER) {
#pragma unroll
            for (int h = 0; h < 2; ++h)
#pragma unroll
                for (int i = 0; i < 2; ++i) cvo[h][i] = nvo[h][i]; }
        if (wr == 1) PG8_BAR;
    }
    PG8_WAIT_V(0);
    PG8_BAR;
#undef PG8_SA
#undef PG8_SB
#undef PG8_STAGE
#undef PG8_LDA
#undef PG8_LDB
#undef PG8_F8OP
#undef PG8_MMA
#undef PG8_WAIT_V
#undef PG8_WAIT_L
#undef PG8_BAR
#undef PG8_SCHED
}
}
using pg8::Unit;
typedef const f32x4 (&AccRef)[2][2][4][2];

#define EPI_G(g) const int ai = (g) >> 2, m = (g) & 3, rowc = ai * 128 + m * 16; (void)ai; (void)m; (void)rowc
__device__ __forceinline__ void store8c(char* p, f32x4 a, f32x4 b) { *(u32x4*)p = pack8u(a, b); }
template <int NS> __device__ __forceinline__ void ss_load8(f32x4 (&v)[8], const char* ssu, unsigned slo, int fq) {
#pragma unroll
    for (int g = 0; g < 8; ++g) { EPI_G(g); v[g] = (f32x4){0.f, 0.f, 0.f, 0.f}; if (NS == 16 || 4 * fq < NS) v[g] = *(const f32x4*)(ssu + slo + rowc * 64); }
}
__device__ __forceinline__ float ss_rstd(f32x4 v, float inv_dim) { float s = (v[0] + v[1]) + (v[2] + v[3]); s = red_fq(s); return 1.0f / sqrtf(s * inv_dim + EPS); }
struct EpiLat {
    const float* ssh; bf16_t* CQ; bf16_t* CKV; bf16_t* KR; float* sslat; const float* cs;
    __device__ __forceinline__ void operator()(AccRef acc, const Unit& u, int wr, int wc, int fr, int fq) const {
        const size_t rowU = (size_t)u.pm * 256 + wr * 64;
        const char* ssu = (const char*)(ssh + rowU * 16); const unsigned slo = (unsigned)(fr * 16 + 4 * fq) * 4u;
        char* sso = (char*)(sslat + rowU * 16); const unsigned sso_l = (unsigned)(fr * 16) * 4u;
        char* cqu = (char*)(CQ + rowU * 384); const unsigned cql = (unsigned)(fr * 384 + fq * 8) * 2u;
        char* cku = (char*)(CKV + rowU * 256 + wc * 32); const unsigned ckl = (unsigned)(fr * 256 + fq * 8) * 2u;
        char* kru = (char*)(KR + rowU * 64); const unsigned krl = (unsigned)(fr * 64 + fq * 8) * 2u;
        const char* csu = (const char*)(cs + rowU * 64); const unsigned csl = (unsigned)(fr * 64 + fq * 16) * 4u;
        float rsv[8];
        { f32x4 sv[8]; ss_load8<16>(sv, ssu, slo, fq);
#pragma unroll
          for (int g = 0; g < 8; ++g) rsv[g] = ss_rstd(sv[g], 1.0f / 1024.0f); }
        asm volatile("" ::: "memory");
        const bool ropew = (u.pn == 1 && wc == 0);
#pragma unroll
        for (int gb = 0; gb < 8; gb += 2) {
            f32x4 ct[2][4];
            if (ropew) {
#pragma unroll
                for (int gg = 0; gg < 2; ++gg) { EPI_G(gb + gg); const f32x4* cp = (const f32x4*)(csu + csl + rowc * 256); ct[gg][0] = cp[0]; ct[gg][1] = cp[1]; ct[gg][2] = cp[2]; ct[gg][3] = cp[3]; }
            }
#pragma unroll
            for (int gg = 0; gg < 2; ++gg) { EPI_G(gb + gg);
                const float rs = rsv[gb + gg];
                const f32x4 v00 = acc[ai][0][m][0] * rs, v01 = acc[ai][0][m][1] * rs, v10 = acc[ai][1][m][0] * rs, v11 = acc[ai][1][m][1] * rs;
                float sq = (sq4(v00) + sq4(v01)) + (sq4(v10) + sq4(v11));
                int slot;
                if (u.pn == 0) { store8c(cqu + cql + (rowc * 384 + wc * 32) * 2, v00, v01); store8c(cqu + cql + (rowc * 384 + 128 + wc * 32) * 2, v10, v11); slot = wc; }
                else if (u.pn == 2) { store8c(cku + ckl + rowc * 512, v00, v01); store8c(cku + ckl + rowc * 512 + 256, v10, v11); slot = 8 + wc; }
                else { slot = 4 + wc;
                    if (wc == 0) { f32x4 a0, a1, b0, b1;
                        rope4(v00, v10, ct[gg][0], ct[gg][1], a0, b0); rope4(v01, v11, ct[gg][2], ct[gg][3], a1, b1);
                        store8c(kru + krl + rowc * 128, a0, a1); store8c(kru + krl + rowc * 128 + 64, b0, b1); sq = 0.f; }
                    else { store8c(cqu + cql + (rowc * 384 + 256 + (wc - 1) * 32) * 2, v00, v01); if (wc == 1) store8c(cqu + cql + (rowc * 384 + 352) * 2, v10, v11); } }
                sq = red_fq(sq);
                if (fq == 0) *(float*)(sso + sso_l + rowc * 64 + slot * 4) = sq;
            }
        }
    }
};
struct EpiQ {
    const float* sslat; bf16_t* Q; const float* cs;
    __device__ __forceinline__ void operator()(AccRef acc, const Unit& u, int wr, int wc, int fr, int fq) const {
        const size_t rowU = (size_t)u.pm * 256 + wr * 64;
        const char* ssu = (const char*)(sslat + rowU * 16); const unsigned slo = (unsigned)(fr * 16 + 4 * fq) * 4u;
        char* qu = (char*)(Q + rowU * 1536); const unsigned ql = (unsigned)(fr * 1536 + fq * 8) * 2u;
        const char* csu = (const char*)(cs + rowU * 64); const unsigned csl = (unsigned)(fr * 64 + fq * 16) * 4u;
        const int hh = (u.pn - 4) * 4 + wc;
        float rsv[8];
        { f32x4 sv[8]; ss_load8<8>(sv, ssu, slo, fq);
#pragma unroll
          for (int g = 0; g < 8; ++g) rsv[g] = ss_rstd(sv[g], 1.0f / 384.0f); }
        asm volatile("" ::: "memory");
        const bool ropet = (u.pn >= 4);
#pragma unroll
        for (int gb = 0; gb < 8; gb += 4) {
            f32x4 ct[4][4];
            if (ropet) {
#pragma unroll
                for (int gg = 0; gg < 4; ++gg) { EPI_G(gb + gg); const f32x4* cp = (const f32x4*)(csu + csl + rowc * 256); ct[gg][0] = cp[0]; ct[gg][1] = cp[1]; ct[gg][2] = cp[2]; ct[gg][3] = cp[3]; }
            }
#pragma unroll
            for (int gg = 0; gg < 4; ++gg) { EPI_G(gb + gg);
                const float rs = rsv[gb + gg];
                const f32x4 v00 = acc[ai][0][m][0] * rs, v01 = acc[ai][0][m][1] * rs, v10 = acc[ai][1][m][0] * rs, v11 = acc[ai][1][m][1] * rs;
                if (!ropet) { store8c(qu + ql + (rowc * 1536 + (2 * u.pn) * 192 + wc * 32) * 2, v00, v01); store8c(qu + ql + (rowc * 1536 + (2 * u.pn + 1) * 192 + wc * 32) * 2, v10, v11); }
                else { f32x4 a0, a1, b0, b1;
                    rope4(v00, v10, ct[gg][0], ct[gg][1], a0, b0); rope4(v01, v11, ct[gg][2], ct[gg][3], a1, b1);
                    store8c(qu + ql + (rowc * 1536 + hh * 192 + 128) * 2, a0, a1); store8c(qu + ql + (rowc * 1536 + hh * 192 + 160) * 2, b0, b1); }
            }
        }
    }
};
template <int NS> struct EpiScale {
    const float* ss; int slot_lo; float inv_dim; bf16_t* O; int pitch;
    __device__ __forceinline__ void operator()(AccRef acc, const Unit& u, int wr, int wc, int fr, int fq) const {
        const size_t rowU = (size_t)u.pm * 256 + wr * 64;
        const char* ssu = (const char*)(ss + rowU * 16 + slot_lo); const unsigned slo = (unsigned)(fr * 16 + 4 * fq) * 4u;
        char* ou = (char*)(O + rowU * pitch + u.pn * 256 + wc * 32); const unsigned ol = (unsigned)(fr * pitch + fq * 8) * 2u;
        f32x4 sv[8]; ss_load8<NS>(sv, ssu, slo, fq);
#pragma unroll
        for (int g = 0; g < 8; ++g) { EPI_G(g);
            const float rs = ss_rstd(sv[g], inv_dim);
            char* p = ou + ol + (size_t)rowc * pitch * 2;
            store8c(p, acc[ai][0][m][0] * rs, acc[ai][0][m][1] * rs); store8c(p + 256, acc[ai][1][m][0] * rs, acc[ai][1][m][1] * rs);
        }
    }
};
struct EpiSwaQkv {
    const float* ssh; bf16_t* Q; bf16_t* KVB; const float* bq; const float* kvb;
    __device__ __forceinline__ void operator()(AccRef acc, const Unit& u, int wr, int wc, int fr, int fq) const {
        const bool iskv = (u.pn == 4);
        const size_t rowU = (size_t)u.pm * 256 + wr * 64;
        const char* bpu = (const char*)((iskv ? kvb : bq + u.pn * 256) + wc * 32); const unsigned bl = (unsigned)(fq * 8) * 4u;
        const f32x4 b00 = *(const f32x4*)(bpu + bl), b01 = *(const f32x4*)(bpu + bl + 16), b10 = *(const f32x4*)(bpu + bl + 512), b11 = *(const f32x4*)(bpu + bl + 528);
        const char* ssu = (const char*)(ssh + rowU * 16); const unsigned slo = (unsigned)(fr * 16 + 4 * fq) * 4u;
        const int pitch = iskv ? 256 : 1024;
        char* ou = iskv ? (char*)(KVB + rowU * 256 + wc * 32) : (char*)(Q + rowU * 1024 + u.pn * 256 + wc * 32); const unsigned ol = (unsigned)(fr * pitch + fq * 8) * 2u;
        f32x4 sv[8]; ss_load8<16>(sv, ssu, slo, fq);
#pragma unroll
        for (int g = 0; g < 8; ++g) { EPI_G(g);
            const float rs = ss_rstd(sv[g], 1.0f / 1024.0f);
            char* p = ou + ol + (size_t)rowc * pitch * 2;
            store8c(p, acc[ai][0][m][0] * rs + b00, acc[ai][0][m][1] * rs + b01); store8c(p + 256, acc[ai][1][m][0] * rs + b10, acc[ai][1][m][1] * rs + b11);
        }
    }
};
struct EpiResid {
    bf16_t* H; float* ss; const float* bias; unsigned char* H8; float descale;
    __device__ __forceinline__ void operator()(AccRef acc, const Unit& u, int wr, int wc, int fr, int fq) const {
        const size_t rowU = (size_t)u.pm * 256 + wr * 64;
        f32x4 b00 = {0.f, 0.f, 0.f, 0.f}, b01 = b00, b10 = b00, b11 = b00;
        if (bias) { const char* bpu = (const char*)(bias + u.pn * 256 + wc * 32); const unsigned bl = (unsigned)(fq * 8) * 4u;
            b00 = *(const f32x4*)(bpu + bl); b01 = *(const f32x4*)(bpu + bl + 16); b10 = *(const f32x4*)(bpu + bl + 512); b11 = *(const f32x4*)(bpu + bl + 528); }
        char* hu = (char*)(H + rowU * 1024 + u.pn * 256 + wc * 32); const unsigned hl = (unsigned)(fr * 1024 + fq * 8) * 2u;
        char* sso = (char*)(ss + rowU * 16 + u.pn * 4 + wc); const unsigned sso_l = (unsigned)(fr * 16) * 4u;
        char* h8u = (char*)(H8 + rowU * 1024 + u.pn * 256 + wc * 32); const unsigned h8l = (unsigned)(fr * 1024 + fq * 8);
        u32x4 hw[8][2];
#pragma unroll
        for (int g = 0; g < 8; ++g) { EPI_G(g); const char* p = hu + hl + rowc * 2048; hw[g][0] = *(const u32x4*)p; hw[g][1] = *(const u32x4*)(p + 256); }
#pragma unroll
        for (int g = 0; g < 8; ++g) { EPI_G(g);
            char* p = hu + hl + rowc * 2048;
            f32x4 h00, h01, h10, h11; unpack8(hw[g][0], h00, h01); unpack8(hw[g][1], h10, h11);
            h00 += acc[ai][0][m][0] * descale + b00; h01 += acc[ai][0][m][1] * descale + b01; h10 += acc[ai][1][m][0] * descale + b10; h11 += acc[ai][1][m][1] * descale + b11;
            store8c(p, h00, h01); store8c(p + 256, h10, h11);
            if (H8) { u32x2 q0, q1; q0.x = pack4_fp8(h00); q0.y = pack4_fp8(h01); q1.x = pack4_fp8(h10); q1.y = pack4_fp8(h11);
                *(u32x2*)(h8u + h8l + rowc * 1024) = q0; *(u32x2*)(h8u + h8l + rowc * 1024 + 128) = q1; }
            float sq = (sq4(h00) + sq4(h01)) + (sq4(h10) + sq4(h11));
            sq = red_fq(sq);
            if (fq == 0) *(float*)(sso + sso_l + rowc * 64) = sq;
        }
    }
};
struct EpiSwiGlu {
    const float* ssh; bf16_t* ACT; int pitch; const int* idx;
    __device__ __forceinline__ void operator()(AccRef acc, const Unit& u, int wr, int wc, int fr, int fq) const {
        const size_t rowU = (size_t)u.pm * 256 + wr * 64;
        const char* ssu = (const char*)(ssh + rowU * 16); const unsigned slo = (unsigned)(fr * 16 + 4 * fq) * 4u;
        char* au = (char*)(ACT + rowU * pitch + u.pn * 128 + wc * 32); const unsigned al = (unsigned)(fr * pitch + fq * 8) * 2u;
        const char* iu = (const char*)(idx + rowU); const unsigned il = (unsigned)fr * 4u;
        f32x4 sv[8];
        if (idx) { int t[8];
#pragma unroll
            for (int g = 0; g < 8; ++g) { EPI_G(g); t[g] = *(const int*)(iu + il + rowc * 4); }
#pragma unroll
            for (int g = 0; g < 8; ++g) { const int tt = t[g] < 0 ? 0 : t[g]; sv[g] = *(const f32x4*)((const char*)ssh + (unsigned)(tt * 16 + 4 * fq) * 4u); }
        } else ss_load8<16>(sv, ssu, slo, fq);
#pragma unroll
        for (int g = 0; g < 8; ++g) { EPI_G(g);
            const float rs = ss_rstd(sv[g], 1.0f / 1024.0f);
            const float c1 = -1.4426950408889634f * rs, c2 = rs * rs;
            const f32x4 a0 = silu_mul_rs(acc[ai][0][m][0], acc[ai][1][m][0], c1, c2), a1 = silu_mul_rs(acc[ai][0][m][1], acc[ai][1][m][1], c1, c2);
            store8c(au + al + (size_t)rowc * pitch * 2, a0, a1);
        }
    }
};
struct EpiSwiGlu8 {
    const float* rsl; unsigned char* ACT; int pitch;
    __device__ __forceinline__ void operator()(AccRef acc, const Unit& u, int wr, int wc, int fr, int fq) const {
        const size_t rowU = (size_t)u.pm * 256 + wr * 64;
        char* au = (char*)(ACT + rowU * pitch + u.pn * 128 + wc * 32); const unsigned al = (unsigned)(fr * pitch + fq * 8);
#pragma unroll
        for (int g = 0; g < 8; ++g) { EPI_G(g);
            f32x4 a0, a1;
#pragma unroll
            for (int e = 0; e < 4; ++e) { const float g0 = acc[ai][0][m][0][e], g1 = acc[ai][0][m][1][e];
                a0[e] = (g0 * acc[ai][1][m][0][e]) * __builtin_amdgcn_rcpf(1.0f + __builtin_amdgcn_exp2f(g0));
                a1[e] = (g1 * acc[ai][1][m][1][e]) * __builtin_amdgcn_rcpf(1.0f + __builtin_amdgcn_exp2f(g1)); }
            u32x2 w; w.x = pack4_fp8(a0); w.y = pack4_fp8(a1);
            *(u32x2*)(au + al + (size_t)rowc * pitch) = w;
        }
    }
};
struct EpiSwiGlu8D {
    const float* ssh; unsigned char* ACT; int pitch;
    __device__ __forceinline__ void operator()(AccRef acc, const Unit& u, int wr, int wc, int fr, int fq) const {
        const size_t rowU = (size_t)u.pm * 256 + wr * 64;
        const char* ssu = (const char*)(ssh + rowU * 16); const unsigned slo = (unsigned)(fr * 16 + 4 * fq) * 4u;
        char* au = (char*)(ACT + rowU * pitch + u.pn * 128 + wc * 32); const unsigned al = (unsigned)(fr * pitch + fq * 8);
        f32x4 sv[8]; ss_load8<16>(sv, ssu, slo, fq);
#pragma unroll
        for (int g = 0; g < 8; ++g) { EPI_G(g);
            const float rs = ss_rstd(sv[g], 1.0f / 1024.0f) * (1.0f / SCALE_GU);
            const float c1 = -1.4426950408889634f * rs, c2 = rs * rs;
            const f32x4 a0 = silu_mul_rs(acc[ai][0][m][0], acc[ai][1][m][0], c1, c2), a1 = silu_mul_rs(acc[ai][0][m][1], acc[ai][1][m][1], c1, c2);
            u32x2 w; w.x = pack4_fp8(a0); w.y = pack4_fp8(a1);
            *(u32x2*)(au + al + (size_t)rowc * pitch) = w;
        }
    }
};
struct EpiMoeDown {
    const bf16_t* Hin; bf16_t* Hout; float* ss; const int* idx; const float* wl; int final_; float descale;
    __device__ __forceinline__ void operator()(AccRef acc, const Unit& u, int wr, int wc, int fr, int fq) const {
        const size_t rowU = (size_t)u.pm * 256 + wr * 64;
        const char* iu = (const char*)(idx + rowU); const char* wu = (const char*)(wl + rowU); const unsigned il = (unsigned)fr * 4u;
        const char* hiu = (const char*)(Hin + u.pn * 256 + wc * 32); char* hou = (char*)(Hout + u.pn * 256 + wc * 32);
        char* sso = (char*)(ss + u.pn * 4 + wc);
        int tk[8]; float wg[8];
#pragma unroll
        for (int g = 0; g < 8; ++g) { EPI_G(g); tk[g] = *(const int*)(iu + il + rowc * 4); wg[g] = *(const float*)(wu + il + rowc * 4); }
        u32x4 hw[8][2];
#pragma unroll
        for (int g = 0; g < 8; ++g) { const int tt = tk[g] < 0 ? 0 : tk[g]; const unsigned ho = (unsigned)(tt * 1024 + fq * 8) * 2u; hw[g][0] = *(const u32x4*)(hiu + ho); hw[g][1] = *(const u32x4*)(hiu + ho + 256); }
#pragma unroll
        for (int g = 0; g < 8; ++g) { EPI_G(g);
            const int tok = tk[g]; const float w = wg[g] * descale;
            float sq = 0.f;
            f32x4 h00, h01, h10, h11; unpack8(hw[g][0], h00, h01); unpack8(hw[g][1], h10, h11);
            h00 += acc[ai][0][m][0] * w; h01 += acc[ai][0][m][1] * w; h10 += acc[ai][1][m][0] * w; h11 += acc[ai][1][m][1] * w;
            if (tok >= 0) {
                const unsigned ho = (unsigned)(tok * 1024 + fq * 8) * 2u;
                store8c(hou + ho, h00, h01); store8c(hou + ho + 256, h10, h11);
                sq = (sq4(h00) + sq4(h01)) + (sq4(h10) + sq4(h11));
            }
            if (final_) { sq = red_fq(sq); if (fq == 0 && tok >= 0) *(float*)(sso + (unsigned)(tok * 16) * 4u) = sq; }
        }
    }
};

namespace att {
#define KSWZ(row, colB) ((row) * 256 + ((colB) ^ (((row) & 7) << 4)))
#define SBAR() __builtin_amdgcn_sched_barrier(0)
__device__ __forceinline__ int v_st(int k, int c) { const int kk = (k & ~0xC) | ((k & 4) << 1) | ((k & 8) >> 1); return ((kk >> 3) * 4 + (c >> 5)) * 512 + ((kk & 7) * 32 + (c & 31)) * 2; }
__device__ __forceinline__ int v_rd_base(int lane) { return ((lane & 3) << 3) | (((lane >> 2) & 3) << 6) | (((lane >> 4) & 1) << 5) | (((lane >> 5) & 1) << 8); }
__device__ __forceinline__ int crow(int r, int hi) { return (r & 3) + 8 * (r >> 2) + 4 * hi; }
#define PK4(P, B_, OUT) do { unsigned a0 = cvtpk(P[B_+0], P[B_+1]), a1 = cvtpk(P[B_+2], P[B_+3]);                          \
        unsigned b0 = cvtpk(P[B_+4], P[B_+5]), b1 = cvtpk(P[B_+6], P[B_+7]);                                             \
        auto r0 = __builtin_amdgcn_permlane32_swap(a0, b0, false, false); auto r1 = __builtin_amdgcn_permlane32_swap(a1, b1, false, false); \
        u32x4 w = {r0[0], r1[0], r0[1], r1[1]}; OUT = __builtin_bit_cast(bf16x8, w); } while (0)
#define TRRD(dst, base, off) asm volatile("ds_read_b64_tr_b16 %0, %1 offset:%2" : "=&v"(dst) : "v"(base), "i"(off) : "memory")
#define MKB(l, h) (bf16x8){l[0], l[1], l[2], l[3], h[0], h[1], h[2], h[3]}
}

__device__ __forceinline__ void glds16_1(const void* sbase, unsigned voff, unsigned ldsaddr) {
    asm volatile("s_mov_b32 m0, %2\n\ts_nop 0\n\tglobal_load_lds_dwordx4 %0, %1" :: "v"(voff), "s"(sbase), "s"(ldsaddr) : "memory"); }
__device__ __forceinline__ void mla_attn_block(const bf16_t* __restrict__ Q, const bf16_t* __restrict__ KV, const bf16_t* __restrict__ KR, bf16_t* __restrict__ O, int b, int h, int qb, LAS char* lds,
                                               const bool pre, const int nb, const int nh, const int nqb) {
    using namespace att;
    constexpr float SCALE = 0.07216878364870323f, C2 = 1.4426950408889634f * SCALE, THR = 8.f;
    int tid = threadIdx.x; asm volatile("" : "+v"(tid));
    const int wid = __builtin_amdgcn_readfirstlane(tid >> 6), lane = tid & 63, r32 = lane & 31, hi = lane >> 5;
    LAS char* V_lds = lds; LAS char* K_lds = lds + 49152; LAS char* R_lds = lds + 98304;
    LAS float* wsf = (LAS float*)(lds + 122880) + wid * 64; LAS float* li_l = wsf; LAS float* al_l = wsf + 32;
    const size_t tok0 = (size_t)b * SEQ;
    const int P0 = qb * 256, NT = (P0 + 256) / 64;
    bf16x8 qr[12];
    { const char* Qu = (const char*)(Q + (tok0 + P0 + wid * 32) * 1536 + h * 192); const unsigned qo = (unsigned)(r32 * 1536 + hi * 8) * 2u;
#pragma unroll
      for (int d0 = 0; d0 < 12; ++d0) qr[d0] = *(const bf16x8*)(Qu + qo + d0 * 32); }
    const char* Ku = (const char*)(KV + tok0 * 2048 + h * 256); const char* Ru = (const char*)(KR + tok0 * 64);
    unsigned kof[2], vof[2], rof;
#pragma unroll
    for (int jj = 0; jj < 2; ++jj) { const int j = 2 * wid + jj;
        { const int row = 4 * j + (lane >> 4); kof[jj] = (unsigned)(row * 4096 + ((16 * (lane & 15)) ^ ((row & 7) << 4))); }
        { const int sub = 2 * j + (lane >> 5), kk = (sub >> 2) * 8 + ((lane & 31) >> 2), k = (kk & ~0xC) | ((kk & 4) << 1) | ((kk & 8) >> 1), c = (sub & 3) * 32 + 8 * (lane & 3);
          vof[jj] = (unsigned)(k * 4096 + 256 + c * 2); } }
    { const int row = 8 * wid + (lane >> 3); rof = (unsigned)(row * 128 + ((16 * (lane & 7)) ^ ((row & 7) << 4))); }
    const unsigned ldsK = (unsigned)(uintptr_t)K_lds + (unsigned)(2 * wid) * 1024u, ldsV = (unsigned)(uintptr_t)V_lds + (unsigned)(2 * wid) * 1024u, ldsR = (unsigned)(uintptr_t)R_lds + (unsigned)wid * 1024u;
#define TLOAD(k0, sg) do { const char* ku_ = Ku + (size_t)(k0) * 4096; const char* ru_ = Ru + (size_t)(k0) * 128; \
        glds16_1(ku_, kof[0], ldsK + (sg) * 16384); glds16_1(ku_, kof[1], ldsK + (sg) * 16384 + 1024); \
        glds16_1(ku_, vof[0], ldsV + (sg) * 16384); glds16_1(ku_, vof[1], ldsV + (sg) * 16384 + 1024); \
        glds16_1(ru_, rof, ldsR + (sg) * 8192); } while (0)
    if (!pre) { TLOAD(0, 0); TLOAD(64, 1); }
    asm volatile("s_waitcnt vmcnt(0)" ::: "memory");
    __syncthreads();
    float m_reg = -1e30f, l_reg = 0.f; f32x16 o[4];
#pragma unroll
    for (int d = 0; d < 4; ++d) o[d] = f32x16{};
    const int vb0 = (int)(uintptr_t)V_lds + v_rd_base(lane);
    const int qlo = P0 + wid * 32, qm = qlo + r32 - 4 * hi;
    const int kq0 = KSWZ(r32, (0 * 16 + hi * 8) * 2), kq1 = KSWZ(r32, (1 * 16 + hi * 8) * 2), kq2 = KSWZ(r32, (2 * 16 + hi * 8) * 2), kq3 = KSWZ(r32, (3 * 16 + hi * 8) * 2);
    const int rq_sw = (r32 & 7) << 4;
    bf16x8 pa0, pa1, pa2, pa3;
#define QKT(P0_, P1_, sg) do { P0_ = f32x16{}; P1_ = f32x16{}; \
        { LAS const char* kb = K_lds + (sg) * 16384; \
          _Pragma("unroll") for (int d0 = 0; d0 < 8; ++d0) { const int ko = ((d0 & 3) == 0 ? kq0 : (d0 & 3) == 1 ? kq1 : (d0 & 3) == 2 ? kq2 : kq3) + (d0 >> 2) * 128; \
              const bf16x8 b0 = *(LAS const bf16x8*)(kb + ko), b1 = *(LAS const bf16x8*)(kb + ko + 8192); \
              P0_ = __builtin_amdgcn_mfma_f32_32x32x16_bf16(b0, qr[d0], P0_, 0, 0, 0); P1_ = __builtin_amdgcn_mfma_f32_32x32x16_bf16(b1, qr[d0], P1_, 0, 0, 0); } \
          LAS const char* rb = R_lds + (sg) * 8192 + r32 * 128; \
          _Pragma("unroll") for (int dd = 0; dd < 4; ++dd) { const int ro = ((dd * 16 + hi * 8) * 2) ^ rq_sw; \
              const bf16x8 b0 = *(LAS const bf16x8*)(rb + ro), b1 = *(LAS const bf16x8*)(rb + ro + 4096); \
              P0_ = __builtin_amdgcn_mfma_f32_32x32x16_bf16(b0, qr[8 + dd], P0_, 0, 0, 0); P1_ = __builtin_amdgcn_mfma_f32_32x32x16_bf16(b1, qr[8 + dd], P1_, 0, 0, 0); } } } while (0)
#define MASKT(P0_, P1_, t_) do { const int kbase = (t_) * 64; \
        if (kbase + 63 > qlo) { const float NEG = -__builtin_inff(); const int dq = qm - kbase; \
            _Pragma("unroll") for (int r = 0; r < 16; ++r) { const int c = (r & 3) + 8 * (r >> 2); if (dq - c < 0) P0_[r] = NEG; if (dq - c - 32 < 0) P1_[r] = NEG; } } } while (0)
    float pmax, mnL, ps, alv;
#define SMXC(c, X0_, X1_) do { \
        if ((c) == 0) { pmax = X0_[0]; _Pragma("unroll") for (int r = 1; r < 16; ++r) pmax = fmaxf(pmax, X0_[r]); } \
        else if ((c) == 1) { _Pragma("unroll") for (int r = 0; r < 16; ++r) pmax = fmaxf(pmax, X1_[r]); \
            { auto rr = __builtin_amdgcn_permlane32_swap(__float_as_uint(pmax), __float_as_uint(pmax), false, false); pmax = fmaxf(__uint_as_float(rr[0]), __uint_as_float(rr[1])); } \
            const bool keep = __all((pmax - m_reg) * SCALE <= THR); const float mn = keep ? m_reg : fmaxf(m_reg, pmax); \
            alv = __builtin_amdgcn_exp2f((m_reg - mn) * C2); m_reg = mn; mnL = -mn * C2; ps = 0.f; } \
        else if ((c) < 10) { _Pragma("unroll") for (int r = 2 * ((c) - 2); r < 2 * ((c) - 2) + 2; ++r) { \
                X0_[r] = __builtin_amdgcn_exp2f(fmaf(X0_[r], C2, mnL)); X1_[r] = __builtin_amdgcn_exp2f(fmaf(X1_[r], C2, mnL)); ps += X0_[r]; ps += X1_[r]; } } \
        else if ((c) == 10) { { auto rr = __builtin_amdgcn_permlane32_swap(__float_as_uint(ps), __float_as_uint(ps), false, false); ps = __uint_as_float(rr[0]) + __uint_as_float(rr[1]); } \
            l_reg = l_reg * alv + ps; PK4(X0_, 0, pa0); PK4(X0_, 8, pa1); } \
        else { PK4(X1_, 0, pa2); PK4(X1_, 8, pa3); } } while (0)
#define SMXALL(X0_, X1_) do { _Pragma("unroll") for (int c_ = 0; c_ < 12; ++c_) SMXC(c_, X0_, X1_); } while (0)
#define RESCALE(alpha_) do { if (__any(alpha_ < 1.f)) { if (hi == 0) al_l[r32] = alpha_; asm volatile("s_waitcnt lgkmcnt(0)" ::: "memory"); \
            _Pragma("unroll") for (int d_ = 0; d_ < 4; ++d_) _Pragma("unroll") for (int r = 0; r < 16; ++r) o[d_][r] *= al_l[crow(r, hi)]; } } while (0)
#define KFRAG(d, sg, f0, f1) do { if ((d) < 8) { const int ko = (((d) & 3) == 0 ? kq0 : ((d) & 3) == 1 ? kq1 : ((d) & 3) == 2 ? kq2 : kq3) + ((d) >> 2) * 128; LAS const char* kb_ = K_lds + (sg) * 16384; \
            f0 = *(LAS const bf16x8*)(kb_ + ko); f1 = *(LAS const bf16x8*)(kb_ + ko + 8192); } \
        else { const int ro = ((((d) - 8) * 16 + hi * 8) * 2) ^ rq_sw; LAS const char* rb_ = R_lds + (sg) * 8192 + r32 * 128; f0 = *(LAS const bf16x8*)(rb_ + ro); f1 = *(LAS const bf16x8*)(rb_ + ro + 4096); } } while (0)
#define QK_SMX(Y0_, Y1_, sg, X0_, X1_) do { Y0_ = f32x16{}; Y1_ = f32x16{}; bf16x8 cf0, cf1; KFRAG(0, sg, cf0, cf1); \
        _Pragma("unroll") for (int d = 0; d < 12; ++d) { bf16x8 nf0 = cf0, nf1 = cf1; if (d + 1 < 12) KFRAG(d + 1, sg, nf0, nf1); \
            Y0_ = __builtin_amdgcn_mfma_f32_32x32x16_bf16(cf0, qr[d], Y0_, 0, 0, 0); Y1_ = __builtin_amdgcn_mfma_f32_32x32x16_bf16(cf1, qr[d], Y1_, 0, 0, 0); \
            SMXC(d, X0_, X1_); SBAR(); cf0 = nf0; cf1 = nf1; } } while (0)
#define PV_D0(vb, d0) do { s16x4 l0, l1, l2, l3, h0, h1, h2, h3; constexpr int b_ = (d0) * 512; \
            TRRD(l0, vb, b_); TRRD(h0, vb, b_ + 2048); TRRD(l1, vb, b_ + 4096); TRRD(h1, vb, b_ + 6144); TRRD(l2, vb, b_ + 8192); TRRD(h2, vb, b_ + 10240); TRRD(l3, vb, b_ + 12288); TRRD(h3, vb, b_ + 14336); \
            asm volatile("s_waitcnt lgkmcnt(0)" ::: "memory"); SBAR(); \
            o[d0] = __builtin_amdgcn_mfma_f32_32x32x16_bf16(pa0, MKB(l0, h0), o[d0], 0, 0, 0); o[d0] = __builtin_amdgcn_mfma_f32_32x32x16_bf16(pa1, MKB(l1, h1), o[d0], 0, 0, 0); \
            o[d0] = __builtin_amdgcn_mfma_f32_32x32x16_bf16(pa2, MKB(l2, h2), o[d0], 0, 0, 0); o[d0] = __builtin_amdgcn_mfma_f32_32x32x16_bf16(pa3, MKB(l3, h3), o[d0], 0, 0, 0); } while (0)
#define PVT(sg) do { const int vb_ = vb0 + (sg) * 16384; PV_D0(vb_, 0); PV_D0(vb_, 1); PV_D0(vb_, 2); PV_D0(vb_, 3); } while (0)
#define ENDSTEP() do { asm volatile("s_waitcnt vmcnt(0)" ::: "memory"); __syncthreads(); } while (0)
    f32x16 pA0, pA1, pB0, pB1;
    QKT(pA0, pA1, 0);
    int sg = 0;
#pragma unroll 1
    for (int t = 0; t < NT; t += 2) {
        const int s1 = sg == 2 ? 0 : sg + 1, s2 = s1 == 2 ? 0 : s1 + 1;
        if (t + 2 < NT) TLOAD((t + 2) * 64, s2);
        MASKT(pA0, pA1, t); SBAR();
        QK_SMX(pB0, pB1, s1, pA0, pA1);
        RESCALE(alv); PVT(sg);
        ENDSTEP();
        if (t + 3 < NT) TLOAD((t + 3) * 64, sg);
        MASKT(pB0, pB1, t + 1); SBAR();
        if (t + 2 < NT) QK_SMX(pA0, pA1, s2, pB0, pB1); else SMXALL(pB0, pB1);
        RESCALE(alv); PVT(s1);
        ENDSTEP();
        sg = s2;
    }
    if (nqb >= 0) {
        const size_t ntok0 = (size_t)nb * SEQ;
        const char* KuN = (const char*)(KV + ntok0 * 2048 + nh * 256); const char* RuN = (const char*)(KR + ntok0 * 64);
#define TLOADN(k0, sg_) do { const char* ku_ = KuN + (size_t)(k0) * 4096; const char* ru_ = RuN + (size_t)(k0) * 128; \
        glds16_1(ku_, kof[0], ldsK + (sg_) * 16384); glds16_1(ku_, kof[1], ldsK + (sg_) * 16384 + 1024); \
        glds16_1(ku_, vof[0], ldsV + (sg_) * 16384); glds16_1(ku_, vof[1], ldsV + (sg_) * 16384 + 1024); \
        glds16_1(ru_, rof, ldsR + (sg_) * 8192); } while (0)
        TLOADN(0, 0); TLOADN(64, 1);
#undef TLOADN
    }
#undef TLOAD
#undef QKT
#undef SMXC
#undef SMXALL
#undef KFRAG
#undef QK_SMX
#undef MASKT
#undef RESCALE
#undef PV_D0
#undef PVT
#undef ENDSTEP
    if (hi == 0) li_l[r32] = l_reg; asm volatile("s_waitcnt lgkmcnt(0)" ::: "memory");
    char* Ou = (char*)(O + (tok0 + P0 + wid * 32) * 1024 + h * 128); const unsigned oo = (unsigned)(4 * hi * 1024 + r32) * 2u;
    unsigned char* O8u = (unsigned char*)O + (tok0 + P0 + wid * 32) * 1024 + h * 128; const unsigned oo8 = (unsigned)(4 * hi * 1024 + r32);
#pragma unroll
    for (int r = 0; r < 16; ++r) { const float rl = __builtin_amdgcn_rcpf(li_l[crow(r, hi)]) * (F8_WOM ? SCALE_O : 1.0f);
#pragma unroll
        for (int d0 = 0; d0 < 4; ++d0) { const float v = o[d0][r] * rl; const float vn = qx1(v);
            if (F8_WOM) { const float v2 = qx2(v), v3 = qx3(v);
                if ((r32 & 3) == 0) *(unsigned*)((char*)O8u + oo8 + (((r & 3) + 8 * (r >> 2)) * 1024 + d0 * 32)) = pack4_fp8((f32x4){v, vn, v2, v3}); }
            else if ((r32 & 1) == 0) *(unsigned*)(Ou + oo + (((r & 3) + 8 * (r >> 2)) * 1024 + d0 * 32) * 2) = cvtpk(v, vn); } }
    __syncthreads();
}

__device__ __forceinline__ void swa_attn_unit(const bf16_t* __restrict__ Q, const bf16_t* __restrict__ KVB, bf16_t* __restrict__ O, const int* __restrict__ positions, const float* __restrict__ sinks,
                                              int b, int ib, LAS char* lds, LAS int* posl, LAS const float* biasd, LAS float* wscr) {
    using namespace att;
    int tid = threadIdx.x; asm volatile("" : "+v"(tid));
    const int wid = __builtin_amdgcn_readfirstlane(tid >> 6), lane = tid & 63, r32 = lane & 31, hi = lane >> 5;
    LAS char* V_lds = lds; LAS char* K_lds = lds + 65536;
    LAS float* li_l = wscr + wid * 64;
    const size_t tok0 = (size_t)b * SEQ + (size_t)ib * 128;
    { const int sr = tid >> 4, sc = (tid & 15) * 8;
#pragma unroll
      for (int tl = 0; tl < 4; ++tl)
#pragma unroll
        for (int hf = 0; hf < 2; ++hf) { const int row = hf * 32 + sr; bf16x8 kx = bf16x8{}, vx = bf16x8{};
            if (ib > 0 || tl >= 2) { const bf16_t* g = KVB + (tok0 - 128 + tl * 64 + row) * 256 + sc; kx = *(const bf16x8*)g; vx = *(const bf16x8*)(g + 128); }
            *(LAS bf16x8*)(K_lds + tl * 16384 + KSWZ(row, sc * 2)) = kx; *(LAS bf16x8*)(V_lds + tl * 16384 + v_st(row, sc)) = vx; }
      if (tid < 128) posl[tid] = positions[tok0 + tid];
      if (tid < 256) posl[128 + tid] = (ib > 0 || tid >= 128) ? positions[tok0 - 128 + tid] : 0; }
    __syncthreads();
    const int kvh = wid >> 2;
    for (int it = 0; it < 8; ++it) {
        const int hq = 2 * wid + (it >> 2), s = it & 3;
        bf16x8 qr[4];
        { const bf16_t* Qw = Q + (tok0 + 32 * s + r32) * 1024 + hq * 64 + hi * 8;
#pragma unroll
          for (int d0 = 0; d0 < 4; ++d0) qr[d0] = *(const bf16x8*)(Qw + d0 * 16); }
        f32x16 p[5];
        { LAS const char* kb = K_lds + s * 8192 + kvh * 128;
          const int k0 = KSWZ(r32, (0 * 16 + hi * 8) * 2), k1 = KSWZ(r32, (1 * 16 + hi * 8) * 2), k2 = KSWZ(r32, (2 * 16 + hi * 8) * 2), k3 = KSWZ(r32, (3 * 16 + hi * 8) * 2);
#pragma unroll
          for (int jj = 0; jj < 5; ++jj) { p[jj] = f32x16{};
#pragma unroll
              for (int d0 = 0; d0 < 4; ++d0) { const int ko = (d0 == 0 ? k0 : d0 == 1 ? k1 : d0 == 2 ? k2 : k3) + jj * 8192;
                  p[jj] = __builtin_amdgcn_mfma_f32_32x32x16_bf16(*(LAS const bf16x8*)(kb + ko), qr[d0], p[jj], 0, 0, 0); } } }
        const float sink = sinks[hq];
        const int qp = posl[32 * s + r32];
        LAS const float* bd = biasd + hq * 132;
        const float NEG = -__builtin_inff();
        float mx = sink;
#pragma unroll
        for (int jj = 0; jj < 5; ++jj) {
            if (ib > 0 || s + jj >= 4) {
                float bv[16];
#pragma unroll
                for (int g = 0; g < 4; ++g) {
                    const i32x4 kp4 = *(LAS const i32x4*)(posl + 128 + 32 * (s + jj) + 8 * g + 4 * hi);
#pragma unroll
                    for (int e = 0; e < 4; ++e) { int dist = qp - kp4[e]; dist = dist < 0 ? 0 : (dist > 128 ? 128 : dist); bv[4 * g + e] = bd[dist]; } }
#pragma unroll
                for (int r = 0; r < 16; ++r) { const int rel = 128 + r32 - 32 * jj - (8 * (r >> 2) + 4 * hi + (r & 3));
                    float v = fmaf(p[jj][r], 0.125f, bv[r]);
                    if (jj == 0) v = rel < 128 ? v : NEG;
                    if (jj == 4) v = rel >= 0 ? v : NEG;
                    p[jj][r] = v; mx = fmaxf(mx, v); }
            } else {
#pragma unroll
                for (int r = 0; r < 16; ++r) p[jj][r] = NEG;
            }
        }
        { auto rr = __builtin_amdgcn_permlane32_swap(__float_as_uint(mx), __float_as_uint(mx), false, false); mx = fmaxf(__uint_as_float(rr[0]), __uint_as_float(rr[1])); }
        float ps = 0.f; const float mL = -mx * 1.4426950408889634f;
#pragma unroll
        for (int jj = 0; jj < 5; ++jj)
#pragma unroll
            for (int r = 0; r < 16; ++r) { p[jj][r] = __builtin_amdgcn_exp2f(fmaf(p[jj][r], 1.4426950408889634f, mL)); ps += p[jj][r]; }
        { auto rr = __builtin_amdgcn_permlane32_swap(__float_as_uint(ps), __float_as_uint(ps), false, false); ps = __uint_as_float(rr[0]) + __uint_as_float(rr[1]); }
        ps += __builtin_amdgcn_exp2f(fmaf(sink, 1.4426950408889634f, mL));
        if (hi == 0) li_l[r32] = ps;
        f32x16 o0 = f32x16{}, o1 = f32x16{};
        { const int vb = (int)(uintptr_t)V_lds + v_rd_base(lane) + s * 8192 + kvh * 1024;
#pragma unroll
          for (int jj = 0; jj < 5; ++jj) { bf16x8 pa, pb; PK4(p[jj], 0, pa); PK4(p[jj], 8, pb);
              s16x4 l0, h0, l1, h1, l2, h2, l3, h3;
              switch (jj) {
#define SWA_RD(J) TRRD(l0, vb, (J) * 8192); TRRD(h0, vb, (J) * 8192 + 2048); TRRD(l1, vb, (J) * 8192 + 4096); TRRD(h1, vb, (J) * 8192 + 6144); \
                  TRRD(l2, vb, (J) * 8192 + 512); TRRD(h2, vb, (J) * 8192 + 512 + 2048); TRRD(l3, vb, (J) * 8192 + 512 + 4096); TRRD(h3, vb, (J) * 8192 + 512 + 6144)
                  case 0: SWA_RD(0); break; case 1: SWA_RD(1); break; case 2: SWA_RD(2); break; case 3: SWA_RD(3); break; default: SWA_RD(4); break;
#undef SWA_RD
              }
              asm volatile("s_waitcnt lgkmcnt(0)" ::: "memory"); SBAR();
              o0 = __builtin_amdgcn_mfma_f32_32x32x16_bf16(pa, MKB(l0, h0), o0, 0, 0, 0); o0 = __builtin_amdgcn_mfma_f32_32x32x16_bf16(pb, MKB(l1, h1), o0, 0, 0, 0);
              o1 = __builtin_amdgcn_mfma_f32_32x32x16_bf16(pa, MKB(l2, h2), o1, 0, 0, 0); o1 = __builtin_amdgcn_mfma_f32_32x32x16_bf16(pb, MKB(l3, h3), o1, 0, 0, 0); } }
        asm volatile("s_waitcnt lgkmcnt(0)" ::: "memory");
        bf16_t* Ow = O + (tok0 + 32 * s) * 1024 + hq * 64;
#pragma unroll
        for (int r = 0; r < 16; ++r) { const int orow = crow(r, hi); const float rl = __builtin_amdgcn_rcpf(li_l[orow]) * (F8_WOS ? SCALE_O : 1.0f);
            const float v0 = o0[r] * rl, v1 = o1[r] * rl; const float v0n = qx1(v0), v1n = qx1(v1);
            if (F8_WOS) { const float v02 = qx2(v0), v03 = qx3(v0), v12 = qx2(v1), v13 = qx3(v1);
                if ((r32 & 3) == 0) { unsigned char* o8 = (unsigned char*)O + (tok0 + 32 * s + orow) * 1024 + hq * 64 + r32;
                    *(unsigned*)o8 = pack4_fp8((f32x4){v0, v0n, v02, v03}); *(unsigned*)(o8 + 32) = pack4_fp8((f32x4){v1, v1n, v12, v13}); } }
            else if ((r32 & 1) == 0) { *(unsigned*)(Ow + (size_t)orow * 1024 + r32) = cvtpk(v0, v0n); *(unsigned*)(Ow + (size_t)orow * 1024 + 32 + r32) = cvtpk(v1, v1n); } }
        asm volatile("s_waitcnt lgkmcnt(0)" ::: "memory");
    }
    __syncthreads();
}

#define XB_TMO      128
#define XB_XCNT(j)  (256  + 64 * (j))
#define XB_XSUB(j)  (1280 + 64 * (j))
#define XB_XGEN(j)  (2304 + 64 * (j))
#define XB_TOP      3328
#define XB_TOPGEN   3392
#define XCD_BAR_WORDS 3456
#define XB_SPIN_CAP (1u << 22)
__device__ __forceinline__ unsigned xb_ld(unsigned* p)              { return __hip_atomic_load(p, __ATOMIC_RELAXED, __HIP_MEMORY_SCOPE_AGENT); }
__device__ __forceinline__ unsigned xb_add(unsigned* p, unsigned v) { return __hip_atomic_fetch_add(p, v, __ATOMIC_RELAXED, __HIP_MEMORY_SCOPE_AGENT); }
__device__ __forceinline__ unsigned xb_xcc_id() { return (unsigned)__builtin_amdgcn_s_getreg((3 << 11) | 20) & 0xFu; }
#define XB_SPIN(cond, bar) do { unsigned _sp = 0; while (cond) { __builtin_amdgcn_s_sleep(1); \
    if ((++_sp & 255u) == 0u) { if (xb_ld(&(bar)[XB_TMO])) break; if (_sp > XB_SPIN_CAP) { atomicAdd(&(bar)[XB_TMO], 1u); break; } } } } while (0)
struct XcdBarrier { unsigned* bar; unsigned x; volatile LAS unsigned* st; };
__device__ __forceinline__ XcdBarrier xcd_barrier_post(unsigned* bar, volatile LAS unsigned* st) {
    XcdBarrier b; b.bar = bar; b.x = xb_xcc_id(); b.st = st;
    if (threadIdx.x == 0) (void)xb_add(&bar[XB_XCNT(b.x)], 1u);
    return b;
}
__device__ __forceinline__ void xcd_barrier_complete(unsigned* bar, unsigned x, unsigned& nloc, unsigned& nx) {
    const unsigned G = gridDim.x * gridDim.y * gridDim.z;
    unsigned sum, cnt, mine, sp = 0u;
    for (;;) {
        sum = 0u; cnt = 0u; mine = 0u;
#pragma unroll
        for (unsigned j = 0; j < 16; ++j) { const unsigned c = xb_ld(&bar[XB_XCNT(j)]); sum += c; cnt += (c > 0u) ? 1u : 0u; mine = (j == x) ? c : mine; }
        if (sum == G) break;
        __builtin_amdgcn_s_sleep(1);
        if ((++sp & 255u) == 0u) { if (xb_ld(&bar[XB_TMO])) break; if (sp > XB_SPIN_CAP) { atomicAdd(&bar[XB_TMO], 1u); break; } }
    }
    nloc = mine > 0u ? mine : 1u; nx = cnt > 0u ? cnt : 1u;
}
__device__ __forceinline__ void xcd_barrier(const XcdBarrier& b) {
    asm volatile("s_waitcnt vmcnt(0)" ::: "memory");
    __syncthreads();
    if (threadIdx.x == 0) {
        unsigned* bar = b.bar;
        __builtin_amdgcn_s_waitcnt(0);
        unsigned nloc = b.st[0], nx = b.st[1];
        if (nloc == 0u) { xcd_barrier_complete(bar, b.x, nloc, nx); b.st[0] = nloc; b.st[1] = nx; }
        const unsigned old = xb_add(&bar[XB_XSUB(b.x)], 1u);
        const unsigned gen = old / nloc;
        if (old + 1u == (gen + 1u) * nloc) {
            __builtin_amdgcn_fence(__ATOMIC_RELEASE, "agent");
            asm volatile("s_waitcnt vmcnt(0)" ::: "memory");
            const unsigned og = xb_add(&bar[XB_TOP], 1u);
            const unsigned tg = og / nx;
            if (og + 1u == (tg + 1u) * nx) xb_add(&bar[XB_TOPGEN], 1u);
            else XB_SPIN(xb_ld(&bar[XB_TOPGEN]) == tg, bar);
            __builtin_amdgcn_fence(__ATOMIC_ACQUIRE, "agent");
            xb_add(&bar[XB_XGEN(b.x)], 1u);
            asm volatile("s_waitcnt vmcnt(0)" ::: "memory");
        } else {
            XB_SPIN(xb_ld(&bar[XB_XGEN(b.x)]) == gen, bar);
            __builtin_amdgcn_fence(__ATOMIC_ACQUIRE, "agent");
            asm volatile("s_waitcnt vmcnt(0)" ::: "memory");
        }
    }
    __syncthreads();
}

__device__ __forceinline__ void cvt_item(const float* __restrict__ W, int K, int N, int sn0, const float* __restrict__ gain, bf16_t* __restrict__ dst, int dn0, int k0, LAS float* scr, int lane) {
    if (sn0 >= 0) {
        f32x4 v[8];
#pragma unroll
        for (int i = 0; i < 8; ++i) { const int kk = 8 * i + (lane >> 3); v[i] = *(const f32x4*)(W + (size_t)(k0 + kk) * N + sn0 + 4 * (lane & 7)); }
#pragma unroll
        for (int i = 0; i < 8; ++i) { const int kk = 8 * i + (lane >> 3); const float gk = gain ? gain[k0 + kk] : 1.0f; LAS float* d = scr + kk * 33 + 4 * (lane & 7);
            d[0] = v[i][0] * gk; d[1] = v[i][1] * gk; d[2] = v[i][2] * gk; d[3] = v[i][3] * gk; }
    } else {
#pragma unroll 8
        for (int i = 0; i < 32; ++i) { const int kk = 2 * i + (lane >> 5); scr[kk * 33 + (lane & 31)] = 0.f; }
    }
    asm volatile("s_waitcnt lgkmcnt(0)" ::: "memory");
    const int c = lane & 7;
#pragma unroll
    for (int j = 0; j < 4; ++j) { const int n = (lane >> 3) + 8 * j; const LAS float* s = scr + (8 * c) * 33 + n;
        u32x4 o; o.x = cvtpk(s[0 * 33], s[1 * 33]); o.y = cvtpk(s[2 * 33], s[3 * 33]); o.z = cvtpk(s[4 * 33], s[5 * 33]); o.w = cvtpk(s[6 * 33], s[7 * 33]);
        *(u32x4*)(dst + (size_t)(dn0 + n) * K + k0 + 8 * c) = o; }
    asm volatile("s_waitcnt lgkmcnt(0)" ::: "memory");
}

__device__ __forceinline__ void cvt_item8(const float* __restrict__ W, int K, int N, int sn0, const float* __restrict__ gain, float scale, unsigned char* __restrict__ dst, int dn0, int k0, LAS float* scr, int lane) {
    { f32x4 v[8];
#pragma unroll
      for (int i = 0; i < 8; ++i) { const int kk = 8 * i + (lane >> 3); v[i] = *(const f32x4*)(W + (size_t)(k0 + kk) * N + sn0 + 4 * (lane & 7)); }
#pragma unroll
      for (int i = 0; i < 8; ++i) { const int kk = 8 * i + (lane >> 3); const float gk = gain ? gain[k0 + kk] * scale : scale; LAS float* d = scr + kk * 33 + 4 * (lane & 7);
          d[0] = v[i][0] * gk; d[1] = v[i][1] * gk; d[2] = v[i][2] * gk; d[3] = v[i][3] * gk; } }
    asm volatile("s_waitcnt lgkmcnt(0)" ::: "memory");
    const int n = lane >> 1, hf = lane & 1; const LAS float* sp = scr + (32 * hf) * 33 + n;
    u32x4 o0, o1;
#pragma unroll
    for (int q = 0; q < 4; ++q) { f32x4 v; v[0] = sp[(4 * q + 0) * 33]; v[1] = sp[(4 * q + 1) * 33]; v[2] = sp[(4 * q + 2) * 33]; v[3] = sp[(4 * q + 3) * 33]; o0[q] = pack4_fp8(v); }
#pragma unroll
    for (int q = 0; q < 4; ++q) { f32x4 v; v[0] = sp[(16 + 4 * q + 0) * 33]; v[1] = sp[(16 + 4 * q + 1) * 33]; v[2] = sp[(16 + 4 * q + 2) * 33]; v[3] = sp[(16 + 4 * q + 3) * 33]; o1[q] = pack4_fp8(v); }
    unsigned char* p = dst + (size_t)(dn0 + n) * K + k0 + 32 * hf;
    *(u32x4*)p = o0; *(u32x4*)(p + 16) = o1;
    asm volatile("s_waitcnt lgkmcnt(0)" ::: "memory");
}

struct Args { const void* in[27]; float* out; unsigned char* ws; int ph_lo, ph_hi; };

__global__ void __launch_bounds__(512, 2) yoco_fwd(Args args) {
    extern __shared__ __attribute__((aligned(16))) unsigned char lds_raw[];
    LAS unsigned char* lds = (LAS unsigned char*)lds_raw;
    volatile LAS unsigned* MISC = (volatile LAS unsigned*)(lds + MISC_OFF);
    const int tid0 = threadIdx.x;
#define PH_TID int tid = threadIdx.x; asm volatile("" : "+v"(tid)); const int lane = tid & 63, wave = __builtin_amdgcn_readfirstlane(tid >> 6); const int gw = vcu * 8 + wave; (void)lane; (void)gw
    const int G = gridDim.x, bx = blockIdx.x;
    const int vcu = (G % 8 == 0) ? (bx % 8) * (G / 8) + bx / 8 : bx;
    unsigned char* ws = args.ws;
    unsigned* ctl = (unsigned*)(ws + WS_CTL);
    for (int u = tid0; u < (LDS_BYTES - LDSCTL_OFF) / 4; u += 512) ((LAS unsigned*)(lds + LDSCTL_OFF))[u] = 0u;
    __syncthreads();
    XcdBarrier bar; bar.bar = ctl + CW_BAR; bar.x = 0; bar.st = nullptr;
    if (!MK_PER_PHASE) bar = xcd_barrier_post(ctl + CW_BAR, MISC + 8);
    const int lo = args.ph_lo, hi = args.ph_hi;
#ifndef PH_MASK
#define PH_MASK 0xffffff
#endif
#define PHE(bit) ((PH_MASK >> (bit)) & 1)
#define IN(k) (lo <= (k) && (k) < hi)
#define GRID_BAR(k) do { if (!MK_PER_PHASE && hi > (k) + 1) xcd_barrier(bar); } while (0)

#define x_in ((const float*)args.in[0])
#define positions ((const int*)args.in[1])
#define mla_w_in ((const float*)args.in[2])
#define mla_g_q ((const float*)args.in[3])
#define mla_g_kv ((const float*)args.in[4])
#define mla_w_uq ((const float*)args.in[5])
#define mla_w_ukv ((const float*)args.in[6])
#define mla_w_o ((const float*)args.in[7])
#define kv_g ((const float*)args.in[8])
#define kv_w ((const float*)args.in[9])
#define kv_b ((const float*)args.in[10])
#define swa_w_q ((const float*)args.in[11])
#define swa_b_q ((const float*)args.in[12])
#define swa_sinks ((const float*)args.in[13])
#define swa_w_o ((const float*)args.in[14])
#define swa_b_o ((const float*)args.in[15])
#define rel_bias ((const float*)args.in[16])
#define g_attn ((const float*)args.in[17])
#define g_ffn ((const float*)args.in[18])
#define ffn_w_gate ((const float*)args.in[19])
#define ffn_w_up ((const float*)args.in[20])
#define ffn_w_down ((const float*)args.in[21])
#define moe_w_router ((const float*)args.in[22])
#define moe_w_gate ((const float*)args.in[23])
#define moe_w_up ((const float*)args.in[24])
#define moe_w_down ((const float*)args.in[25])
#define g_final ((const float*)args.in[26])
#define hA ((bf16_t*)(ws + WS_H))
#define ssh ((float*)(ws + WS_SS))
#define KVB ((bf16_t*)(ws + WS_KVB))
#define arena (ws + WS_ARENA)
#define rt (ws + WS_ROUTE)
#define CQ ((bf16_t*)(arena + AR_CQ))
#define CKV ((bf16_t*)(arena + AR_CKV))
#define KRb ((bf16_t*)(arena + AR_KR))
#define Qm ((bf16_t*)(arena + AR_Q))
#define Om ((bf16_t*)(arena + AR_O))
#define cs ((float*)(arena + AR_CS))
#define sslat ((float*)(arena + AR_SSLAT))
#define hA8 (arena + AR_H8)
#define ACT8 (arena + AR_ACT)
#define ACT ((bf16_t*)(arena + AR_ACT))
#define Qs ((bf16_t*)(arena + AR_SQ))
#define Os ((bf16_t*)(arena + AR_SO))
#define KVm ((bf16_t*)args.out)
#define hB ((bf16_t*)args.out)
#define tok_e ((int*)(rt + RT_TOKE))
#define tok_w ((float*)(rt + RT_TOKW))
#define tok_rank ((int*)(rt + RT_RANK))
#define cnts ((int*)(rt + RT_CNT))
#define pcnts ((int*)(rt + RT_PCNT))
#define idxs ((int*)(rt + RT_IDX))
#define wls ((float*)(rt + RT_WL))
#define texp_g ((int*)(rt + RT_TEXP))
#define rsls ((float*)(rt + RT_RSL))
    const int NGW = G * 8;

    if (PHE(0) && IN(0)) {
        PH_TID;
        LAS float* scr = (LAS float*)(lds + wave * 16384);
        int base = 0;
#define CVT_LOOP(NITEMS, ...) do { const int n_ = (NITEMS); int st_ = (gw - base) % NGW; if (st_ < 0) st_ += NGW; for (int it = st_; it < n_; it += NGW) { __VA_ARGS__ } base = (base + n_) % NGW; } while (0)
        for (int a = 0; a < 2; ++a) {
            CVT_LOOP(24 * 16, { const int g = it / 16, kb = it % 16; int sn0;
                if (g < 8) sn0 = 32 * g; else if (g == 8) sn0 = 640; else if (g < 12) sn0 = 256 + 32 * (g - 9); else if (g == 12) sn0 = 672; else if (g == 13) sn0 = 352; else if (g < 16) sn0 = -1; else sn0 = 384 + 32 * (g - 16);
                cvt_item(mla_w_in + (size_t)a * 1024 * LATN, 1024, LATN, sn0, g_attn + a * 1024, (bf16_t*)(ws + WS_WIN + a * SZ_WIN), 32 * g, 64 * kb, scr, lane); });
            CVT_LOOP(48 * 6, { const int g = it / 6, kb = it % 6; int sn0;
                if (g < 32) sn0 = (g >> 2) * 192 + 32 * (g & 3); else { const int gg = g - 32, tile = gg >> 3, half = (gg & 7) >> 2, hh = gg & 3; sn0 = (tile * 4 + hh) * 192 + 128 + 32 * half; }
                cvt_item(mla_w_uq + (size_t)a * 384 * 1536, 384, 1536, sn0, mla_g_q + a * 384, (bf16_t*)(ws + WS_WUQ + a * SZ_WUQ), 32 * g, 64 * kb, scr, lane); });
            CVT_LOOP(64 * 4, { const int g = it / 4, kb = it % 4;
                cvt_item(mla_w_ukv + (size_t)a * 256 * 2048, 256, 2048, 32 * g, mla_g_kv + a * 256, (bf16_t*)(ws + WS_WUKV + a * SZ_WUKV), 32 * g, 64 * kb, scr, lane); });
            CVT_LOOP(32 * 16, { const int g = it / 16, kb = it % 16;
                if (F8_WOM) cvt_item8(mla_w_o + (size_t)a * 1024 * 1024, 1024, 1024, 32 * g, nullptr, SCALE_GU, ws + WS_WOM + a * SZ_WO, 32 * g, 64 * kb, scr, lane);
                else cvt_item(mla_w_o + (size_t)a * 1024 * 1024, 1024, 1024, 32 * g, nullptr, (bf16_t*)(ws + WS_WOM + a * SZ_WO), 32 * g, 64 * kb, scr, lane); });
            CVT_LOOP((a == 0 ? 40 : 32) * 16, { const int g = it / 16, kb = it % 16;
                if (g < 32) cvt_item(swa_w_q + (size_t)a * 1024 * 1024, 1024, 1024, 32 * g, g_attn + (2 + a) * 1024, (bf16_t*)(ws + WS_WQKV + a * SZ_WQKV), 32 * g, 64 * kb, scr, lane);
                else cvt_item(kv_w, 1024, 256, 32 * (g - 32), kv_g, (bf16_t*)(ws + WS_WQKV + a * SZ_WQKV), 32 * g, 64 * kb, scr, lane); });
            CVT_LOOP(32 * 16, { const int g = it / 16, kb = it % 16;
                if (F8_WOS) cvt_item8(swa_w_o + (size_t)a * 1024 * 1024, 1024, 1024, 32 * g, nullptr, SCALE_GU, ws + WS_WOS + a * SZ_WO, 32 * g, 64 * kb, scr, lane);
                else cvt_item(swa_w_o + (size_t)a * 1024 * 1024, 1024, 1024, 32 * g, nullptr, (bf16_t*)(ws + WS_WOS + a * SZ_WO), 32 * g, 64 * kb, scr, lane); });
            CVT_LOOP(176 * 16, { const int g = it / 16, kb = it % 16; const int pn = g >> 3, r = g & 7;
                const float* Wsrc = (r < 4 ? ffn_w_gate : ffn_w_up) + (size_t)a * 1024 * DFF;
                if (F8_D1 && a == 1) cvt_item8(Wsrc, 1024, DFF, 128 * pn + 32 * (r & 3), g_ffn + (2 * a) * 1024, SCALE_GU, ws + WS_WGUD + a * SZ_WGU_D, 32 * g, 64 * kb, scr, lane);
                else cvt_item(Wsrc, 1024, DFF, 128 * pn + 32 * (r & 3), g_ffn + (2 * a) * 1024, (bf16_t*)(ws + WS_WGUD + a * SZ_WGU_D), 32 * g, 64 * kb, scr, lane); });
            CVT_LOOP(32 * 44, { const int g = it / 44, kb = it % 44;
                if (F8_D1 && a == 1) cvt_item8(ffn_w_down + (size_t)a * DFF * 1024, DFF, 1024, 32 * g, nullptr, SCALE_D, ws + WS_WDD + a * SZ_WD_D, 32 * g, 64 * kb, scr, lane);
                else cvt_item(ffn_w_down + (size_t)a * DFF * 1024, DFF, 1024, 32 * g, nullptr, (bf16_t*)(ws + WS_WDD + a * SZ_WD_D), 32 * g, 64 * kb, scr, lane); });
            CVT_LOOP(8 * 224 * 16, { const int e = it / (224 * 16), r0 = it % (224 * 16); const int g = r0 / 16, kb = r0 % 16; const int pn = g >> 3, r = g & 7;
                const float* Wsrc = (r < 4 ? moe_w_gate : moe_w_up) + ((size_t)a * 8 + e) * 1024 * DFE;
                if ((a == 0 ? F8_L0 : F8_L1)) cvt_item8(Wsrc, 1024, DFE, 128 * pn + 32 * (r & 3), g_ffn + (2 * a + 1) * 1024, r < 4 ? SCALE_WG8 : SCALE_WU8, ws + (a == 0 ? WS_WGUE0 + e * SZ_WGU_E0 : WS_WGUE1 + e * SZ_WGU_E1), 32 * g, 64 * kb, scr, lane);
                else cvt_item(Wsrc, 1024, DFE, 128 * pn + 32 * (r & 3), g_ffn + (2 * a + 1) * 1024, (bf16_t*)(ws + (a == 0 ? WS_WGUE0 + e * SZ_WGU_E0 : WS_WGUE1 + e * SZ_WGU_E1)), 32 * g, 64 * kb, scr, lane); });
            CVT_LOOP(8 * 32 * 56, { const int e = it / (32 * 56), r0 = it % (32 * 56); const int g = r0 / 56, kb = r0 % 56;
                if ((a == 0 ? F8_L0 : F8_L1)) cvt_item8(moe_w_down + ((size_t)a * 8 + e) * DFE * 1024, DFE, 1024, 32 * g, nullptr, SCALE_D, ws + (a == 0 ? WS_WDE0 + e * SZ_WD_E0 : WS_WDE1 + e * SZ_WD_E1), 32 * g, 64 * kb, scr, lane);
                else cvt_item(moe_w_down + ((size_t)a * 8 + e) * DFE * 1024, DFE, 1024, 32 * g, nullptr, (bf16_t*)(ws + (a == 0 ? WS_WDE0 + e * SZ_WD_E0 : WS_WDE1 + e * SZ_WD_E1)), 32 * g, 64 * kb, scr, lane); });
        }
#undef CVT_LOOP
        for (int i = gw * 64 + lane; i < 2 * 8 * 1024; i += NGW * 64) { const int j = i >> 13, e = (i >> 10) & 7, k = i & 1023;
            ((float*)(ws + WS_WR))[i] = moe_w_router[(size_t)j * 1024 * 8 + k * 8 + e] * g_ffn[(2 * j + 1) * 1024 + k]; }
        for (int m = gw; m < T; m += NGW) {
            const f32x4* xr = (const f32x4*)(x_in + (size_t)m * DM) + lane; f32x4 v[4]; float s = 0.f;
#pragma unroll
            for (int j = 0; j < 4; ++j) { v[j] = xr[64 * j]; s += sq4(v[j]); }
            s = wave_sum(s);
            u32x2* o8 = (u32x2*)(hA + (size_t)m * DM) + lane;
#pragma unroll
            for (int j = 0; j < 4; ++j) { u32x2 w; w.x = cvtpk(v[j][0], v[j][1]); w.y = cvtpk(v[j][2], v[j][3]); o8[64 * j] = w; }
            if (lane < 16) ssh[(size_t)m * 16 + lane] = lane == 0 ? s : 0.f;
        }
        for (int i = gw * 64 + lane; i < T * 32; i += NGW * 64) { const int t = i >> 5, j = i & 31;
            const float inv = powf(10000.0f, -(float)j / 32.0f); const float ang = (float)positions[t] * inv;
            double rev = (double)ang * 0.15915494309189535; rev -= floor(rev); const float rf = (float)rev;
            f32x2 o; o.x = __builtin_amdgcn_cosf(rf); o.y = __builtin_amdgcn_sinf(rf); *(f32x2*)(cs + (size_t)i * 2) = o; }
        GRID_BAR(0);
    }

    for (int l = 0; l < 4; ++l) {
        const int pb = 1 + l * 10;
        if (l < 2) {
            const int a = l;
            if (PHE(1) && IN(pb + 0)) {
                pg8::Sched S; S.init(T / 256, 3, 1024, G, bx, (const bf16_t*)(ws + WS_WIN + a * SZ_WIN));
                EpiLat E{ssh, CQ, CKV, KRb, sslat, cs};
                pg8::gemm_phase<EpiLat, false>(lds, hA, 1024, S, E);
                GRID_BAR(pb + 0);
            }
            if (PHE(2) && IN(pb + 1)) {
                { pg8::Sched S; S.init(T / 256, 6, 384, G, bx, (const bf16_t*)(ws + WS_WUQ + a * SZ_WUQ));
                  EpiQ E{sslat, Qm, cs};
                  pg8::gemm_phase<EpiQ, false>(lds, CQ, 384, S, E); }
                { pg8::Sched S; S.init(T / 256, 8, 256, G, bx, (const bf16_t*)(ws + WS_WUKV + a * SZ_WUKV));
                  EpiScale<4> E{sslat, 8, 1.0f / 256.0f, KVm, 2048};
                  pg8::gemm_phase<EpiScale<4>, false>(lds, CKV, 256, S, E); }
                GRID_BAR(pb + 1);
            }
            if (PHE(3) && IN(pb + 2)) {
                for (int id = vcu; id < NB * 8 * 4; id += G) { const int bh = id >> 2, xq = id & 3;
#pragma unroll 1
                    for (int hf = 0; hf < 2; ++hf) { const bool pre = !(id == vcu && hf == 0);
                        int nbh = bh, nqb = 7 - xq;
                        if (hf == 1) { const int nid = id + G; if (nid < NB * 8 * 4) { nbh = nid >> 2; nqb = nid & 3; } else nqb = -1; }
                        mla_attn_block(Qm, KVm, KRb, Om, bh >> 3, bh & 7, hf ? 7 - xq : xq, (LAS char*)lds, pre, nbh >> 3, nbh & 7, nqb); } }
                GRID_BAR(pb + 2);
            }
            if (PHE(4) && IN(pb + 3)) {
                if (F8_WOM) { pg8::Sched S; S.init(T / 256, 4, 1024, G, bx, ws + WS_WOM + a * SZ_WO, 1);
                    EpiResid E{hA, ssh, nullptr, nullptr, 1.0f / (SCALE_GU * SCALE_O)};
                    pg8::gemm_phase<EpiResid, false, true>(lds, Om, 1024, S, E); }
                else { pg8::Sched S; S.init(T / 256, 4, 1024, G, bx, (const bf16_t*)(ws + WS_WOM + a * SZ_WO));
                    EpiResid E{hA, ssh, nullptr, nullptr, 1.0f};
                    pg8::gemm_phase<EpiResid, false>(lds, Om, 1024, S, E); }
                GRID_BAR(pb + 3);
            }
        } else {
            const int b2 = l - 2;
            if (PHE(5) && IN(pb + 0)) {
                pg8::Sched S; S.init(T / 256, b2 == 0 ? 5 : 4, 1024, G, bx, (const bf16_t*)(ws + WS_WQKV + b2 * SZ_WQKV));
                EpiSwaQkv E{ssh, Qs, KVB, swa_b_q + b2 * 1024, kv_b};
                pg8::gemm_phase<EpiSwaQkv, false>(lds, hA, 1024, S, E);
                GRID_BAR(pb + 0);
            }
            if (PHE(6) && IN(pb + 2)) {
                PH_TID;
                LAS int* posl = (LAS int*)(lds + LX_POS); LAS float* biasd = (LAS float*)(lds + LX_BIAS); LAS float* wscr = (LAS float*)(lds + LX_WSC);
                if (tid <= 128) { const int n = tid; int bk;
                    if (n < 16) bk = n; else { bk = 16 + (int)(logf((float)n / 16.0f) / 2.0794415416798357f * 16.0f); bk = bk > 31 ? 31 : bk; }
                    for (int hq = 0; hq < 16; ++hq) biasd[hq * 132 + n] = rel_bias[bk * 16 + hq]; }
                __syncthreads();
                for (int id = vcu; id < NB * 16; id += G)
                    swa_attn_unit(Qs, KVB, Os, positions, swa_sinks + b2 * 16, id >> 4, id & 15, (LAS char*)lds, posl, biasd, wscr);
                GRID_BAR(pb + 2);
            }
            if (PHE(7) && IN(pb + 3)) {
                if (F8_WOS) { pg8::Sched S; S.init(T / 256, 4, 1024, G, bx, ws + WS_WOS + b2 * SZ_WO, 1);
                    EpiResid E{hA, ssh, swa_b_o + b2 * 1024, (F8_D1 && b2 == 0) ? (unsigned char*)hA8 : nullptr, 1.0f / (SCALE_GU * SCALE_O)};
                    pg8::gemm_phase<EpiResid, false, true>(lds, Os, 1024, S, E); }
                else { pg8::Sched S; S.init(T / 256, 4, 1024, G, bx, (const bf16_t*)(ws + WS_WOS + b2 * SZ_WO));
                    EpiResid E{hA, ssh, swa_b_o + b2 * 1024, (F8_D1 && b2 == 0) ? (unsigned char*)hA8 : nullptr, 1.0f};
                    pg8::gemm_phase<EpiResid, false>(lds, Os, 1024, S, E); }
                GRID_BAR(pb + 3);
            }
        }
        const int j = l >> 1;
        const bool f8l = (j == 0) ? (F8_L0 != 0) : (F8_L1 != 0);
        if ((l & 1) == 0) {
            const bool f8d = (F8_D1 != 0) && (j == 1);
            if (PHE(8) && IN(pb + 4)) {
                if (f8d) {
                    pg8::Sched S; S.init(T / 256, 22, 1024, G, bx, ws + WS_WGUD + j * SZ_WGU_D, 1);
                    EpiSwiGlu8D E{ssh, ACT8, DFF};
                    pg8::gemm_phase<EpiSwiGlu8D, false, true>(lds, hA8, 1024, S, E);
                } else {
                    pg8::Sched S; S.init(T / 256, 22, 1024, G, bx, (const bf16_t*)(ws + WS_WGUD + j * SZ_WGU_D));
                    EpiSwiGlu E{ssh, ACT, DFF, nullptr};
                    pg8::gemm_phase<EpiSwiGlu, false>(lds, hA, 1024, S, E);
                }
                GRID_BAR(pb + 4);
            }
            if (PHE(9) && IN(pb + 5)) {
                if (f8d) {
                    pg8::Sched S; S.init(T / 256, 4, DFF, G, bx, ws + WS_WDD + j * SZ_WD_D, 1);
                    EpiResid E{hA, ssh, nullptr, nullptr, 1.0f / SCALE_D};
                    pg8::gemm_phase<EpiResid, false, true>(lds, ACT8, DFF, S, E);
                } else {
                    pg8::Sched S; S.init(T / 256, 4, DFF, G, bx, (const bf16_t*)(ws + WS_WDD + j * SZ_WD_D));
                    EpiResid E{hA, ssh, nullptr, nullptr, 1.0f};
                    pg8::gemm_phase<EpiResid, false>(lds, ACT, DFF, S, E);
                }
                GRID_BAR(pb + 5);
            }
        } else {
            if (PHE(10) && IN(pb + 4)) {
                PH_TID;
                const float* WR = (const float*)(ws + WS_WR) + (size_t)j * 8192;
                float wreg[8][16];
#pragma unroll
                for (int e = 0; e < 8; ++e)
#pragma unroll
                    for (int jj = 0; jj < 2; ++jj) { const f32x4 w0 = *(const f32x4*)(WR + e * 1024 + 512 * jj + 8 * lane), w1 = *(const f32x4*)(WR + e * 1024 + 512 * jj + 8 * lane + 4);
#pragma unroll
                        for (int q = 0; q < 4; ++q) { wreg[e][jj * 8 + q] = w0[q]; wreg[e][jj * 8 + 4 + q] = w1[q]; } }
                LAS int* el = (LAS int*)lds;
                LAS int* wcnt = (LAS int*)(lds + 1024);
                for (int ch = bx; ch < T / 256; ch += G) {
                    const size_t tokw = (size_t)ch * 256 + wave * 32;
                    u32x4 n0 = *(const u32x4*)(hA + tokw * 1024 + 8 * lane), n1 = *(const u32x4*)(hA + tokw * 1024 + 512 + 8 * lane);
                    float nsv = lane < 16 ? ssh[tokw * 16 + lane] : 0.f;
#pragma unroll 1
                    for (int i = 0; i < 32; ++i) { const int tl = wave * 32 + i; const size_t tok = tokw + i;
                        const u32x4 h0 = n0, h1 = n1; const float sv0 = nsv;
                        if (i + 1 < 32) { const size_t tn = tok + 1; n0 = *(const u32x4*)(hA + tn * 1024 + 8 * lane); n1 = *(const u32x4*)(hA + tn * 1024 + 512 + 8 * lane); nsv = lane < 16 ? ssh[tn * 16 + lane] : 0.f; }
                        f32x4 f[4]; unpack8(h0, f[0], f[1]); unpack8(h1, f[2], f[3]);
                        float lg[8];
#pragma unroll
                        for (int e = 0; e < 8; ++e) { float s = 0.f;
#pragma unroll
                            for (int q = 0; q < 16; ++q) s = fmaf(f[q >> 2][q & 3], wreg[e][q], s);
                            lg[e] = wave_sum(s); }
                        float sv = wave_sum(sv0);
                        const float rstd = 1.0f / sqrtf(sv * (1.0f / 1024.0f) + EPS);
                        if (f8l) { const float sa = rstd * SCALE_A8;
                            f32x4 fs[4];
#pragma unroll
                            for (int q = 0; q < 4; ++q) fs[q] = f[q] * sa;
                            u32x2 q0, q1; q0.x = pack4_fp8(fs[0]); q0.y = pack4_fp8(fs[1]); q1.x = pack4_fp8(fs[2]); q1.y = pack4_fp8(fs[3]);
                            *(u32x2*)(hA8 + tok * 1024 + 8 * lane) = q0; *(u32x2*)(hA8 + tok * 1024 + 512 + 8 * lane) = q1; }
                        int e1 = 0; float v1 = lg[0];
#pragma unroll
                        for (int e = 1; e < 8; ++e) if (lg[e] > v1) { v1 = lg[e]; e1 = e; }
                        int e2 = -1; float v2 = -__builtin_inff();
#pragma unroll
                        for (int e = 0; e < 8; ++e) if (e != e1 && lg[e] > v2) { v2 = lg[e]; e2 = e; }
                        const float w1 = 1.0f / (1.0f + __expf((v2 - v1) * rstd)), w2 = 1.0f - w1;
                        if (lane == 0) { el[tl] = e1 | (e2 << 8); tok_e[tok] = e1 | (e2 << 8); *(f32x2*)(tok_w + tok * 2) = (f32x2){w1, w2}; }
                    }
                    __syncthreads();
                    LAS int* pwc = (LAS int*)(lds + 2048);
                    int myp = 0;
                    if (tid < 256) { const int ee = el[tid];
#pragma unroll
                        for (int k = 0; k < 2; ++k) { const int ek = (ee >> (8 * k)) & 255;
#pragma unroll
                            for (int e = 0; e < 8; ++e) { const unsigned long long mk = __ballot(ek == e); if (lane == 0) wcnt[(k * 8 + e) * 4 + wave] = __popcll(mk); } }
                        const int pq = (ee & 255) * 8 + (ee >> 8);
#pragma unroll 8
                        for (int q = 0; q < 64; ++q) { const unsigned long long mk = __ballot(pq == q); if (pq == q) myp = __popcll(mk & ((1ull << lane) - 1ull)); if (lane == 0) pwc[q * 4 + wave] = __popcll(mk); } }
                    __syncthreads();
                    if (tid < 256) { const int ee = el[tid]; const int pq = (ee & 255) * 8 + (ee >> 8); int off = 0;
                        for (int w = 0; w < wave; ++w) off += pwc[pq * 4 + w];
                        tok_rank[((size_t)ch * 256 + tid) * 2] = myp + off; }
                    if (tid < 64) pcnts[ch * 64 + tid] = pwc[tid * 4 + 0] + pwc[tid * 4 + 1] + pwc[tid * 4 + 2] + pwc[tid * 4 + 3];
                    if (tid < 16) cnts[ch * 16 + tid] = wcnt[tid * 4 + 0] + wcnt[tid * 4 + 1] + wcnt[tid * 4 + 2] + wcnt[tid * 4 + 3];
                    __syncthreads();
                }
                GRID_BAR(pb + 4);
            }
            if (PHE(11) && IN(pb + 5)) {
                PH_TID;
                LAS int* cl = (LAS int*)lds;
                LAS int* pc = (LAS int*)(lds + 16384);
                LAS int* tot = (LAS int*)(lds + 81920);
                LAS int* seg = tot + 16;
                LAS int* pre = tot + 32;
                LAS int* dft = tot + 48;
                LAS int* Pt = tot + 64;
                LAS int* mpl = tot + 128;
                LAS int* ppre = tot + 192;
                LAS int* wc2 = tot + 256;
                LAS int* dlt = tot + 320;
                for (int i = tid; i < 4096; i += 512) cl[i] = cnts[i];
                for (int i = tid; i < 16384; i += 512) pc[i] = pcnts[i];
                __syncthreads();
                if (tid < 16) { int run = 0; for (int c = 0; c < 256; ++c) run += cl[c * 16 + tid]; dft[tid] = run; }
                if (tid >= 64 && tid < 128) { const int p_ = tid - 64; int run = 0; for (int c = 0; c < 256; ++c) run += pc[c * 64 + p_]; Pt[p_] = run; mpl[p_] = 0; }
                __syncthreads();
                if (tid == 0) { int bs = 0;
                    for (int e = 0; e < 8; ++e) { const int d_ = dft[8 + e] & 255; dlt[8 + e] = d_; dlt[e] = -d_; bs += d_; }
                    const int up = bs >> 8;
                    for (int u = 0; u < up; ++u) { int be = 0, bv = -1; for (int e = 0; e < 8; ++e) { const int d_ = dlt[8 + e]; if (d_ > bv) { bv = d_; be = e; } } dlt[be] = 256 - dlt[8 + be]; dlt[8 + be] = -1; }
                    int ok = 1;
                    for (int a_ = 0; a_ < 8; ++a_) for (int b_ = 0; b_ < 8; ++b_) { const int da = dlt[a_], db = dlt[b_];
                        if (da > 0 && db < 0) { const int mv = da < -db ? da : -db; if (mv > Pt[a_ * 8 + b_]) ok = 0; mpl[a_ * 8 + b_] = mv; dlt[a_] = da - mv; dlt[b_] = db + mv; } }
                    for (int e = 0; e < 8; ++e) if (dlt[e] != 0) ok = 0;
                    if (!ok) for (int q = 0; q < 64; ++q) mpl[q] = 0; }
                __syncthreads();
                if (tid < 16) { const int k = tid >> 3, e = tid & 7; int mo = 0, mi = 0;
                    for (int o = 0; o < 8; ++o) { mo += mpl[e * 8 + o]; mi += mpl[o * 8 + e]; }
                    tot[tid] = dft[tid] + (k == 0 ? mi - mo : mo - mi); }
                __syncthreads();
                if (tid < 16) { const int k = tid >> 3, e = tid & 7; int s = 0; for (int e2 = 0; e2 < e; ++e2) s += (tot[k * 8 + e2] + 255) & ~255; seg[tid] = s; }
                __syncthreads();
                for (int ch = bx; ch < T / 256; ch += G) {
                    if (tid < 64) { int run = 0; for (int c = 0; c < ch; ++c) run += pc[c * 64 + tid]; ppre[tid] = run; }
                    __syncthreads();
                    if (tid < 16) { const int k = tid >> 3, e = tid & 7; int run = 0; for (int c = 0; c < ch; ++c) run += cl[c * 16 + tid];
                        int mo = 0, mi = 0;
                        for (int o = 0; o < 8; ++o) { const int fo = mpl[e * 8 + o] < ppre[e * 8 + o] ? mpl[e * 8 + o] : ppre[e * 8 + o], fi = mpl[o * 8 + e] < ppre[o * 8 + e] ? mpl[o * 8 + e] : ppre[o * 8 + e]; mo += fo; mi += fi; }
                        pre[tid] = run + (k == 0 ? mi - mo : mo - mi); }
                    int ek0 = 0, ek1 = 0, rk0 = 0, rk1 = 0; float wk0 = 0.f, wk1 = 0.f, rstd = 0.f; size_t tok = 0;
                    if (tid < 256) { tok = (size_t)ch * 256 + tid; const int ee = tok_e[tok]; const int e1 = ee & 255, e2 = ee >> 8, pq = e1 * 8 + e2;
                        const bool flip = ppre[pq] + tok_rank[tok * 2] < mpl[pq];
                        const f32x2 w12 = *(const f32x2*)(tok_w + tok * 2);
                        ek0 = flip ? e2 : e1; ek1 = flip ? e1 : e2; wk0 = flip ? w12.y : w12.x; wk1 = flip ? w12.x : w12.y;
                        const f32x4* sp = (const f32x4*)(ssh + tok * 16); const f32x4 s0 = sp[0], s1 = sp[1], s2 = sp[2], s3 = sp[3];
                        const float ssum = ((s0[0] + s0[1]) + (s0[2] + s0[3])) + ((s1[0] + s1[1]) + (s1[2] + s1[3])) + ((s2[0] + s2[1]) + (s2[2] + s2[3])) + ((s3[0] + s3[1]) + (s3[2] + s3[3]));
                        rstd = 1.0f / sqrtf(ssum * (1.0f / 1024.0f) + EPS);
#pragma unroll
                        for (int e = 0; e < 8; ++e) { const unsigned long long mk = __ballot(ek0 == e); if (ek0 == e) rk0 = __popcll(mk & ((1ull << lane) - 1ull)); if (lane == 0) wc2[e * 4 + wave] = __popcll(mk); }
#pragma unroll
                        for (int e = 0; e < 8; ++e) { const unsigned long long mk = __ballot(ek1 == e); if (ek1 == e) rk1 = __popcll(mk & ((1ull << lane) - 1ull)); if (lane == 0) wc2[(8 + e) * 4 + wave] = __popcll(mk); } }
                    __syncthreads();
                    if (tid < 256) { int off0 = 0, off1 = 0;
                        for (int w = 0; w < wave; ++w) { off0 += wc2[ek0 * 4 + w]; off1 += wc2[(8 + ek1) * 4 + w]; }
                        const int pos0 = seg[ek0] + pre[ek0] + rk0 + off0, pos1 = seg[8 + ek1] + pre[8 + ek1] + rk1 + off1;
                        idxs[pos0] = (int)tok; wls[pos0] = wk0; rsls[pos0] = rstd;
                        idxs[(size_t)MOE_ROWS + pos1] = (int)tok; wls[(size_t)MOE_ROWS + pos1] = wk1; rsls[(size_t)MOE_ROWS + pos1] = rstd; }
                    __syncthreads();
                }
                for (int jj = bx; jj < 16; jj += G) { const int k = jj >> 3; const int total = tot[jj], padded = (total + 255) & ~255;
                    for (int r = total + tid; r < padded; r += 512) { idxs[(size_t)k * MOE_ROWS + seg[jj] + r] = -1; wls[(size_t)k * MOE_ROWS + seg[jj] + r] = 0.f; rsls[(size_t)k * MOE_ROWS + seg[jj] + r] = 0.f; } }
                if (bx == 0 && tid < 16) { const int k = tid >> 3, e = tid & 7; const int t0 = seg[tid] >> 8, t1 = (seg[tid] + ((tot[tid] + 255) & ~255)) >> 8;
                    for (int tI = t0; tI < t1; ++tI) texp_g[k * 512 + tI] = e;
                    if (e == 7) texp_g[k * 512 + 300] = t1; }
                GRID_BAR(pb + 5);
            }
            for (int k = 0; k < 2; ++k) {
                const int* idxk = idxs + (size_t)k * MOE_ROWS; const float* wlk = wls + (size_t)k * MOE_ROWS; const int* texpk = texp_g + k * 512;
                if (PHE(12) && IN(pb + 6 + 2 * k)) {
                    const int ntl = __builtin_amdgcn_readfirstlane(texpk[300]);
                    if (f8l) {
                        pg8::Sched S; S.init(ntl, 28, 1024, G, bx, ws + (j == 0 ? WS_WGUE0 : WS_WGUE1), 1); S.texp = texpk; S.estride = (j == 0 ? SZ_WGU_E0 : SZ_WGU_E1); S.idx = idxk;
                        if (k == 1) S.skip(__builtin_amdgcn_readfirstlane((4 * texp_g[300]) % G));
                        EpiSwiGlu8 E{rsls + (size_t)k * MOE_ROWS, ACT8 + (size_t)k * AR_ACTB, DFE};
                        pg8::gemm_phase<EpiSwiGlu8, true, true>(lds, hA8, 1024, S, E);
                    } else {
                        pg8::Sched S; S.init(ntl, 28, 1024, G, bx, ws + (j == 0 ? WS_WGUE0 : WS_WGUE1)); S.texp = texpk; S.estride = (j == 0 ? SZ_WGU_E0 : SZ_WGU_E1); S.idx = idxk;
                        EpiSwiGlu E{ssh, ACT, DFE, idxk};
                        pg8::gemm_phase<EpiSwiGlu, true>(lds, hA, 1024, S, E);
                    }
                    GRID_BAR(pb + 6 + 2 * k);
                }
                if (PHE(13) && IN(pb + 7 + 2 * k)) {
                    const int ntl = __builtin_amdgcn_readfirstlane(texpk[300]);
                    if (f8l) {
                        pg8::Sched S; S.init(ntl, 4, DFE, G, bx, ws + (j == 0 ? WS_WDE0 : WS_WDE1), 1); S.texp = texpk; S.estride = (j == 0 ? SZ_WD_E0 : SZ_WD_E1);
                        EpiMoeDown E{k == 0 ? hA : hB, k == 0 ? hB : hA, ssh, idxk, wlk, k, 1.0f / SCALE_D};
                        pg8::gemm_phase<EpiMoeDown, false, true>(lds, ACT8 + (size_t)k * AR_ACTB, DFE, S, E);
                    } else {
                        pg8::Sched S; S.init(ntl, 4, DFE, G, bx, ws + (j == 0 ? WS_WDE0 : WS_WDE1)); S.texp = texpk; S.estride = (j == 0 ? SZ_WD_E0 : SZ_WD_E1);
                        EpiMoeDown E{k == 0 ? hA : hB, k == 0 ? hB : hA, ssh, idxk, wlk, k, 1.0f};
                        pg8::gemm_phase<EpiMoeDown, false>(lds, ACT, DFE, S, E);
                    }
                    if (!(f8l && k == 0)) GRID_BAR(pb + 7 + 2 * k);
                }
            }
        }
    }
    if (PHE(14) && IN(41)) {
        PH_TID;
        for (int m = gw; m < T; m += NGW) {
            float sv = lane < 16 ? ssh[(size_t)m * 16 + lane] : 0.f; sv = wave_sum(sv);
            const float rstd = 1.0f / sqrtf(sv * (1.0f / 1024.0f) + EPS);
            const u32x2* hr = (const u32x2*)(hA + (size_t)m * DM) + lane; f32x4* orow = (f32x4*)(args.out + (size_t)m * DM) + lane; const f32x4* gr = (const f32x4*)g_final + lane;
#pragma unroll
            for (int jx = 0; jx < 4; ++jx) { const u32x2 w = hr[64 * jx]; const f32x4 g = gr[64 * jx]; f32x4 o;
                o[0] = __uint_as_float(w.x << 16) * rstd * g[0]; o[1] = __uint_as_float(w.x & 0xffff0000u) * rstd * g[1];
                o[2] = __uint_as_float(w.y << 16) * rstd * g[2]; o[3] = __uint_as_float(w.y & 0xffff0000u) * rstd * g[3]; orow[64 * jx] = o; }
        }
    }
#undef IN
#undef GRID_BAR
}

extern "C" void kernel_launch(void* const* d_in, const int* in_sizes, int n_in, void* d_out, int out_size, void* d_ws, size_t ws_size, hipStream_t stream) {
    static int grid = 0;
    if (grid == 0) {
        if (n_in != 27 || out_size != T * DM || ws_size < WS_END) { fprintf(stderr, "kernel_launch: unexpected shapes (n_in %d, out %d, ws %zu, need %zu)\n", n_in, out_size, ws_size, (size_t)WS_END); grid = -1; return; }
        int dev = 0, cus = 0;
        if (hipGetDevice(&dev) != hipSuccess || hipDeviceGetAttribute(&cus, hipDeviceAttributeMultiprocessorCount, dev) != hipSuccess) { grid = -1; return; }
        if (hipFuncSetAttribute((const void*)yoco_fwd, hipFuncAttributeMaxDynamicSharedMemorySize, LDS_BYTES) != hipSuccess) { fprintf(stderr, "kernel_launch: hipFuncSetAttribute failed\n"); grid = -1; return; }
        int per_cu = 0;
        if (hipOccupancyMaxActiveBlocksPerMultiprocessor(&per_cu, (const void*)yoco_fwd, 512, LDS_BYTES) != hipSuccess || per_cu < 1) { fprintf(stderr, "kernel_launch: occupancy query reports %d\n", per_cu); }
        (void)hipGetLastError();
        grid = cus - cus % 8;
    }
    if (grid < 0) return;
    (void)hipMemsetAsync((char*)d_ws + WS_CTL, 0, CTL_BYTES, stream);
    Args a{};
    for (int i = 0; i < 27; ++i) a.in[i] = d_in[i];
    a.out = (float*)d_out; a.ws = (unsigned char*)d_ws;
#if MK_PER_PHASE
    for (int p = 0; p <= 41; ++p) { a.ph_lo = p; a.ph_hi = p + 1; hipLaunchKernelGGL(yoco_fwd, dim3(grid), dim3(512), LDS_BYTES, stream, a); }
#else
    a.ph_lo = 0; a.ph_hi = 1000;
    hipLaunchKernelGGL(yoco_fwd, dim3(grid), dim3(512), LDS_BYTES, stream, a);
#endif
}
```
